# Optimizing an MI355X kernel written in HIP

```python
import math
import jax, jax.numpy as jnp
from jax import lax
import numpy as np

D_MODEL = 2048
BATCH = 32
SEQ = 256
DEPTH = 2
DEC_BATCH = 4
DEC_SEQ = 1024
PAST_LEN = 512

GRID_W = 64
N_EVEN = (DEPTH + 1) // 2
N_ODD = DEPTH // 2
QBLK = 128
ROPE_BASE = 10000.0
EPS = 1e-6
NEG_INF = -1e30

DA_HEADS = 8
DA_QK_DIM = 64
DA_V_DIM = 2 * DA_QK_DIM
MLA_HEADS = 8
MLA_Q_RANK = 512
MLA_KV_RANK = 512
MLA_NOPE = 128
MLA_ROPE = 64
MLA_V = 128
MLA_QK = MLA_NOPE + MLA_ROPE
GQ_HEADS = 16
GQ_KV_HEADS = 4
GQ_GROUP = GQ_HEADS // GQ_KV_HEADS
GQ_DIM = 128
WINDOW = 128
D_FF = 4 * D_MODEL

DA_QW = DA_HEADS * 2 * DA_QK_DIM
DA_VW = DA_HEADS * DA_V_DIM
AB_SPLITS = [DA_QW, 2 * DA_QW, 2 * DA_QW + DA_VW,
             2 * DA_QW + DA_VW + MLA_Q_RANK,
             2 * DA_QW + DA_VW + MLA_Q_RANK + MLA_KV_RANK]
AB_IN = 2 * DA_QW + DA_VW + MLA_Q_RANK + MLA_KV_RANK + MLA_ROPE
AB_OUT = DA_VW + MLA_HEADS * MLA_V
C_SPLITS = [GQ_HEADS * GQ_DIM, GQ_HEADS * GQ_DIM + GQ_KV_HEADS * GQ_DIM]
C_IN = GQ_HEADS * GQ_DIM + 2 * GQ_KV_HEADS * GQ_DIM
C_OUT = GQ_HEADS * GQ_DIM

kernel_name = "hybrid_diffusion_prefix_ctx_step"


def rmsnorm(x, g):
    xf = x.astype(jnp.float32)
    y = xf * lax.rsqrt(jnp.mean(xf * xf, axis=-1, keepdims=True) + EPS)
    return (y * g.astype(jnp.float32)).astype(x.dtype)


def rope_1d(x, pos):
    half = x.shape[-1] // 2
    inv = ROPE_BASE ** (-jnp.arange(half, dtype=jnp.float32) / half)
    ang = pos.astype(jnp.float32)[:, None] * inv
    cos = jnp.cos(ang)[:, None, :].astype(x.dtype)
    sin = jnp.sin(ang)[:, None, :].astype(x.dtype)
    x1, x2 = x[..., :half], x[..., half:]
    return jnp.concatenate([x1 * cos - x2 * sin, x2 * cos + x1 * sin], axis=-1)


def axial_rope(x, pos):
    a = x.shape[-1] // 2
    return jnp.concatenate([rope_1d(x[..., :a], pos[0]), rope_1d(x[..., a:], pos[1])], axis=-1)


def to_blocks(x):
    b, s = x.shape[:2]
    return jnp.swapaxes(x.reshape(b, s // QBLK, QBLK, *x.shape[2:]), 0, 1)


def from_blocks(y):
    nb, b, q = y.shape[:3]
    return jnp.swapaxes(y, 0, 1).reshape(b, nb * q, *y.shape[3:])


def diff_attention(q1, q2, k1, k2, v, lam):
    scale = DA_QK_DIM ** -0.5

    def block(qs):
        b1, b2 = qs
        p1 = jax.nn.softmax(jnp.einsum('bqhd,bkhd->bhqk', b1, k1).astype(jnp.float32) * scale, axis=-1)
        p2 = jax.nn.softmax(jnp.einsum('bqhd,bkhd->bhqk', b2, k2).astype(jnp.float32) * scale, axis=-1)
        a = (p1 - lam * p2).astype(v.dtype)
        return jnp.einsum('bhqk,bkhd->bqhd', a, v)

    return from_blocks(lax.map(block, (to_blocks(q1), to_blocks(q2))))


def softmax_attention(q, k, v):
    scale = q.shape[-1] ** -0.5

    def block(qb):
        p = jax.nn.softmax(jnp.einsum('bqhd,bkhd->bhqk', qb, k).astype(jnp.float32) * scale, axis=-1)
        return jnp.einsum('bhqk,bkhd->bqhd', p.astype(v.dtype), v)

    return from_blocks(lax.map(block, to_blocks(q)))


def sink_window_attention(q, k_ctx, v_ctx, sink, k_lat=None, v_lat=None):
    b, s = q.shape[:2]
    lc = k_ctx.shape[1]
    scale = GQ_DIM ** -0.5
    band = QBLK + 2 * WINDOW
    qg = q.reshape(b, s, GQ_KV_HEADS, GQ_GROUP, GQ_DIM)
    sink_col = sink.astype(jnp.float32).reshape(1, GQ_KV_HEADS, GQ_GROUP, 1, 1)
    if k_lat is not None:
        pad = ((0, 0), (WINDOW, WINDOW), (0, 0), (0, 0))
        kp = jnp.pad(k_lat, pad)
        vp = jnp.pad(v_lat, pad)

    def block(args):
        qb, bi = args
        s_ctx = jnp.einsum('bqhgd,bkhd->bhgqk', qb, k_ctx).astype(jnp.float32) * scale
        sinks = jnp.broadcast_to(sink_col, s_ctx.shape[:-1] + (1,))
        if k_lat is None:
            p = jax.nn.softmax(jnp.concatenate([s_ctx, sinks], axis=-1), axis=-1)
            return jnp.einsum('bhgqk,bkhd->bqhgd', p[..., :lc].astype(v_ctx.dtype), v_ctx)
        kb = lax.dynamic_slice_in_dim(kp, bi * QBLK, band, axis=1)
        vb = lax.dynamic_slice_in_dim(vp, bi * QBLK, band, axis=1)
        s_loc = jnp.einsum('bqhgd,bkhd->bhgqk', qb, kb).astype(jnp.float32) * scale
        qi = bi * QBLK + jnp.arange(QBLK)
        kj = bi * QBLK - WINDOW + jnp.arange(band)
        valid = (jnp.abs(qi[:, None] - kj[None, :]) <= WINDOW) & (kj >= 0)[None, :] & (kj < s)[None, :]
        s_loc = jnp.where(valid, s_loc, NEG_INF)
        p = jax.nn.softmax(jnp.concatenate([s_ctx, s_loc, sinks], axis=-1), axis=-1)
        o = jnp.einsum('bhgqk,bkhd->bqhgd', p[..., :lc].astype(v_ctx.dtype), v_ctx)
        return o + jnp.einsum('bhgqk,bkhd->bqhgd', p[..., lc:lc + band].astype(vb.dtype), vb)

    out = lax.map(block, (to_blocks(qg), jnp.arange(s // QBLK)))
    return from_blocks(out).reshape(b, s, GQ_HEADS * GQ_DIM)


def mla_keys_values(ckv, kr, w_kv_up, k_norm):
    b, l = ckv.shape[:2]
    kv = (ckv @ w_kv_up).reshape(b, l, MLA_HEADS, MLA_NOPE + MLA_V)
    k_nope, v = kv[..., :MLA_NOPE], kv[..., MLA_NOPE:]
    k_rope = jnp.broadcast_to(kr[:, :, None, :], (b, l, MLA_HEADS, MLA_ROPE))
    k = rmsnorm(jnp.concatenate([k_nope, k_rope], axis=-1), k_norm)
    return k, v


def rope_tail(t, pos):
    return jnp.concatenate([t[..., :MLA_NOPE], axial_rope(t[..., MLA_NOPE:], pos)], axis=-1)


def mixer_ab(h, pos, ctx, w_in, w_out, lq1, lk1, lq2, lk2, da_qn, da_kn, da_subln, lam_init,
             mq_norm, w_q_up, mkv_norm, w_kv_up, mla_qn, mla_kn):
    b, s, _ = h.shape
    dq, dk, dv, mq, mkv, mkr = jnp.split(h @ w_in, AB_SPLITS, axis=-1)
    dq = rmsnorm(dq.reshape(b, s, DA_HEADS, 2, DA_QK_DIM), da_qn)
    dk = rmsnorm(dk.reshape(b, s, DA_HEADS, 2, DA_QK_DIM), da_kn)
    dv = dv.reshape(b, s, DA_HEADS, DA_V_DIM)
    q1, q2, k1, k2 = dq[:, :, :, 0], dq[:, :, :, 1], dk[:, :, :, 0], dk[:, :, :, 1]
    q = rmsnorm((rmsnorm(mq, mq_norm) @ w_q_up).reshape(b, s, MLA_HEADS, MLA_QK), mla_qn)
    ckv = rmsnorm(mkv, mkv_norm)
    k, v = mla_keys_values(ckv, mkr, w_kv_up, mla_kn)
    if ctx is None:
        new = (jnp.concatenate([k1, k2], axis=-1), dv, ckv, mkr)
    else:
        c_dak, c_dav, c_ckv, c_kr = ctx
        q1, q2, k1, k2 = [axial_rope(t, pos) for t in (q1, q2, k1, k2)]
        k1 = jnp.concatenate([c_dak[..., :DA_QK_DIM], k1], axis=1)
        k2 = jnp.concatenate([c_dak[..., DA_QK_DIM:], k2], axis=1)
        dv = jnp.concatenate([c_dav, dv], axis=1)
        q = rope_tail(q, pos)
        ck, cv = mla_keys_values(c_ckv, c_kr, w_kv_up, mla_kn)
        k = jnp.concatenate([ck, rope_tail(k, pos)], axis=1)
        v = jnp.concatenate([cv, v], axis=1)
        new = None
    f32 = jnp.float32
    lam = (jnp.exp(jnp.sum(lq1.astype(f32) * lk1.astype(f32)))
           - jnp.exp(jnp.sum(lq2.astype(f32) * lk2.astype(f32))) + lam_init)
    o_da = rmsnorm(diff_attention(q1, q2, k1, k2, dv, lam), da_subln) * (1.0 - lam_init)
    o_mla = softmax_attention(q, k, v)
    o = jnp.concatenate([o_da.reshape(b, s, DA_VW), o_mla.reshape(b, s, MLA_HEADS * MLA_V)], axis=-1)
    return o @ w_out, new


def mixer_c(h, pos, ctx, w_in, w_out, qn, kn, sink):
    b, s, _ = h.shape
    q, k, v = jnp.split(h @ w_in, C_SPLITS, axis=-1)
    q = rmsnorm(q.reshape(b, s, GQ_HEADS, GQ_DIM), qn)
    k = rmsnorm(k.reshape(b, s, GQ_KV_HEADS, GQ_DIM), kn)
    v = v.reshape(b, s, GQ_KV_HEADS, GQ_DIM)
    if ctx is None:
        o = sink_window_attention(q, k, v, sink)
        new = (k, v)
    else:
        o = sink_window_attention(axial_rope(q, pos), ctx[0], ctx[1], sink,
                                  axial_rope(k, pos), v)
        new = None
    return o @ w_out, new


def sqrelu_mlp(h, w1, w2):
    return jnp.square(jax.nn.relu(h @ w1)) @ w2


def run_trunk(x, cond, pos, cache, P):
    new = {"da_k": [], "da_v": [], "mla_ckv": [], "mla_krope": [], "gq_k": [], "gq_v": []}
    for l in range(DEPTH):
        m = (jax.nn.silu(cond) @ P["ada_w"][l] + P["ada_b"][l]).reshape(-1, 1, 6 * D_MODEL)
        sh1, sc1, g1, sh2, sc2, g2 = jnp.split(m, 6, axis=-1)
        h = rmsnorm(x, P["norm1_g"][l]) * (1 + sc1) + sh1
        i = l // 2
        if l % 2 == 0:
            ctx = None if cache is None else (cache["da_k"][:, i], cache["da_v"][:, i],
                                              cache["mla_ckv"][:, i], cache["mla_krope"][:, i])
            y, nc = mixer_ab(h, pos, ctx, P["ab_w_in"][i], P["ab_w_out"][i],
                             P["da_lambda_q1"][i], P["da_lambda_k1"][i],
                             P["da_lambda_q2"][i], P["da_lambda_k2"][i],
                             P["da_q_norm"][i], P["da_k_norm"][i], P["da_subln"][i],
                             0.8 - 0.6 * math.exp(-0.3 * l),
                             P["mla_q_a_norm"][i], P["mla_w_q_up"][i],
                             P["mla_kv_a_norm"][i], P["mla_w_kv_up"][i],
                             P["mla_q_norm"][i], P["mla_k_norm"][i])
            if nc is not None:
                for name, t in zip(("da_k", "da_v", "mla_ckv", "mla_krope"), nc):
                    new[name].append(t)
        else:
            ctx = None if cache is None else (cache["gq_k"][:, i], cache["gq_v"][:, i])
            y, nc = mixer_c(h, pos, ctx, P["c_w_in"][i], P["c_w_out"][i],
                            P["gq_q_norm"][i], P["gq_k_norm"][i], P["gq_sink"][i])
            if nc is not None:
                new["gq_k"].append(nc[0])
                new["gq_v"].append(nc[1])
        x = x + g1 * y
        h = rmsnorm(x, P["norm2_g"][l]) * (1 + sc2) + sh2
        x = x + g2 * sqrelu_mlp(h, P["ff1_w"][l], P["ff2_w"][l])
    return x, new


def setup_inputs(seed: int = 0) -> dict:
    key = jax.random.key(seed)
    ks = iter(jax.random.split(key, 40))
    f32 = jnp.float32

    def nrm(shape, scale=1.0):
        return jax.random.normal(next(ks), shape, f32) * scale

    def gain(shape):
        return 1.0 + 0.02 * jax.random.normal(next(ks), shape, f32)

    D = D_MODEL
    return {
        "x_prompt": nrm((BATCH, SEQ, D)),
        "x_sample": nrm((DEC_BATCH, DEC_SEQ, D)),
        "cache_da_k": nrm((DEC_BATCH, N_EVEN, PAST_LEN, DA_HEADS, 2 * DA_QK_DIM)),
        "cache_da_v": nrm((DEC_BATCH, N_EVEN, PAST_LEN, DA_HEADS, DA_V_DIM)),
        "cache_mla_ckv": nrm((DEC_BATCH, N_EVEN, PAST_LEN, MLA_KV_RANK)),
        "cache_mla_krope": nrm((DEC_BATCH, N_EVEN, PAST_LEN, MLA_ROPE)),
        "cache_gq_k": nrm((DEC_BATCH, N_ODD, PAST_LEN, GQ_KV_HEADS, GQ_DIM)),
        "cache_gq_v": nrm((DEC_BATCH, N_ODD, PAST_LEN, GQ_KV_HEADS, GQ_DIM)),
        "c": nrm((DEC_BATCH, D)),
        "c_ctx": nrm((D,)),
        "norm1_g": gain((DEPTH, D)),
        "norm2_g": gain((DEPTH, D)),
        "ada_w": nrm((DEPTH, D, 6 * D), 0.5 * D ** -0.5),
        "ada_b": nrm((DEPTH, 6 * D), 0.02),
        "ff1_w": nrm((DEPTH, D, D_FF), D ** -0.5),
        "ff2_w": nrm((DEPTH, D_FF, D), D_FF ** -0.5),
        "ab_w_in": nrm((N_EVEN, D, AB_IN), D ** -0.5),
        "ab_w_out": nrm((N_EVEN, AB_OUT, D), AB_OUT ** -0.5),
        "da_lambda_q1": nrm((N_EVEN, DA_QK_DIM), 0.1),
        "da_lambda_k1": nrm((N_EVEN, DA_QK_DIM), 0.1),
        "da_lambda_q2": nrm((N_EVEN, DA_QK_DIM), 0.1),
        "da_lambda_k2": nrm((N_EVEN, DA_QK_DIM), 0.1),
        "da_q_norm": gain((N_EVEN, DA_QK_DIM)),
        "da_k_norm": gain((N_EVEN, DA_QK_DIM)),
        "da_subln": gain((N_EVEN, DA_V_DIM)),
        "mla_q_a_norm": gain((N_EVEN, MLA_Q_RANK)),
        "mla_w_q_up": nrm((N_EVEN, MLA_Q_RANK, MLA_HEADS * MLA_QK), MLA_Q_RANK ** -0.5),
        "mla_kv_a_norm": gain((N_EVEN, MLA_KV_RANK)),
        "mla_w_kv_up": nrm((N_EVEN, MLA_KV_RANK, MLA_HEADS * (MLA_NOPE + MLA_V)), MLA_KV_RANK ** -0.5),
        "mla_q_norm": gain((N_EVEN, MLA_QK)),
        "mla_k_norm": gain((N_EVEN, MLA_QK)),
        "c_w_in": nrm((N_ODD, D, C_IN), D ** -0.5),
        "c_w_out": nrm((N_ODD, C_OUT, D), C_OUT ** -0.5),
        "gq_q_norm": gain((N_ODD, GQ_DIM)),
        "gq_k_norm": gain((N_ODD, GQ_DIM)),
        "gq_sink": nrm((N_ODD, GQ_HEADS), 0.5),
    }


def reference(x_prompt, x_sample, cache_da_k, cache_da_v, cache_mla_ckv, cache_mla_krope,
              cache_gq_k, cache_gq_v, c, c_ctx, norm1_g, norm2_g, ada_w, ada_b, ff1_w, ff2_w,
              ab_w_in, ab_w_out, da_lambda_q1, da_lambda_k1, da_lambda_q2, da_lambda_k2,
              da_q_norm, da_k_norm, da_subln, mla_q_a_norm, mla_w_q_up, mla_kv_a_norm,
              mla_w_kv_up, mla_q_norm, mla_k_norm, c_w_in, c_w_out, gq_q_norm, gq_k_norm,
              gq_sink):
    P = {"norm1_g": norm1_g, "norm2_g": norm2_g, "ada_w": ada_w, "ada_b": ada_b,
         "ff1_w": ff1_w, "ff2_w": ff2_w, "ab_w_in": ab_w_in, "ab_w_out": ab_w_out,
         "da_lambda_q1": da_lambda_q1, "da_lambda_k1": da_lambda_k1,
         "da_lambda_q2": da_lambda_q2, "da_lambda_k2": da_lambda_k2,
         "da_q_norm": da_q_norm, "da_k_norm": da_k_norm, "da_subln": da_subln,
         "mla_q_a_norm": mla_q_a_norm, "mla_w_q_up": mla_w_q_up,
         "mla_kv_a_norm": mla_kv_a_norm, "mla_w_kv_up": mla_w_kv_up,
         "mla_q_norm": mla_q_norm, "mla_k_norm": mla_k_norm,
         "c_w_in": c_w_in, "c_w_out": c_w_out, "gq_q_norm": gq_q_norm,
         "gq_k_norm": gq_k_norm, "gq_sink": gq_sink}
    y_prompt, new = run_trunk(x_prompt, c_ctx, None, None, P)
    s = x_sample.shape[1]
    rows = s // GRID_W
    pos = (jnp.repeat(jnp.arange(rows), GRID_W), jnp.tile(jnp.arange(GRID_W), rows))
    cache = {"da_k": cache_da_k, "da_v": cache_da_v, "mla_ckv": cache_mla_ckv,
             "mla_krope": cache_mla_krope, "gq_k": cache_gq_k, "gq_v": cache_gq_v}
    y_sample, _ = run_trunk(x_sample, c, pos, cache, P)
    new_da_k = jnp.stack(new["da_k"], axis=1)
    new_da_v = jnp.stack(new["da_v"], axis=1)
    new_mla_ckv = jnp.stack(new["mla_ckv"], axis=1)
    new_mla_krope = jnp.stack(new["mla_krope"], axis=1)
    new_gq_k = jnp.stack(new["gq_k"], axis=1)
    new_gq_v = jnp.stack(new["gq_v"], axis=1)
    return (y_prompt, y_sample, new_da_k, new_da_v, new_mla_ckv, new_mla_krope, new_gq_k, new_gq_v)
```

```cpp
#include <hip/hip_runtime.h>
#include <hip/hip_cooperative_groups.h>
#include <cstdio>
#include <cstdint>
namespace cg = cooperative_groups;
namespace pg8 {
#define PG8_LAS __attribute__((address_space(3)))
typedef unsigned short bf16_t;
typedef short bf16x8 __attribute__((ext_vector_type(8)));
typedef float f32x4 __attribute__((ext_vector_type(4)));
typedef unsigned u32x4 __attribute__((ext_vector_type(4)));
constexpr int BM = 256, BK = 64, HALF = 128, HTB = HALF * BK * 2  , STAGE_BYTES = 8 * HTB, NXCD = 8, WGM = 8;

__host__ __device__ __forceinline__ int lds_byte(int r, int c) { const int st = (r >> 4) * 2 + (c >> 5), rr = r & 15, cc = c & 31, ob = rr * 64 + cc * 2; return st * 1024 + (ob ^ (((ob >> 9) & 1) << 5)); }
__host__ __device__ __forceinline__ void stage_rc(int b, int& R, int& C) { const int st = b / 1024, sb = b % 1024, swz = sb ^ (((sb >> 9) & 1) << 5); R = (st >> 1) * 16 + swz / 64; C = (st & 1) * 32 + (swz % 64) / 2; }
__host__ __device__ __forceinline__ int perm32(int rho) { const int n = rho >> 4, i = rho & 15; return 8 * (i >> 2) + 4 * n + (i & 3); }

struct Unit { int pm, pn, koff, nt, role, sj; };
struct Gemm { const bf16_t* A; const bf16_t* Bt; int M, N, K; };

struct StaticOrder {
    int nM, nN, nwg, G, c, ntk;
    __host__ __device__ void init(int M, int N, int K, int G_, int c_) { nM = M / BM; nN = N / BM; nwg = nM * nN; G = G_; c = c_; ntk = K / BK; }
    __host__ __device__ void decode(int wgid, Unit& u) const { { const int q = nwg / NXCD, r = nwg % NXCD, xcd = wgid % NXCD, off = wgid / NXCD; wgid = (xcd < r ? xcd * (q + 1) : r * (q + 1) + (xcd - r) * q) + off; }
        const int nig = WGM * nN, gid = wgid / nig, fm = gid * WGM, gsz = (nM - fm) < WGM ? (nM - fm) : WGM;
        u.pm = fm + ((wgid % nig) % gsz); u.pn = (wgid % nig) / gsz; u.koff = 0; u.nt = ntk; u.role = 0; u.sj = 0; }
    __host__ __device__ bool next(int i, Unit& u) const {
        const long L = (long)i * G + c; if (L >= nwg) return false;
        decode((int)L, u); return true;
    }
    __device__ __forceinline__ void a_ready(const Unit&) const {}
    __device__ __forceinline__ void done(const Unit&) const {}
};
struct HalfShareOrder {
    StaticOrder so; int c; bool share;
    __host__ __device__ void init(int M, int N, int K, int G_, int c_, bool share_) { so.init(M, N, K, G_, c_); c = c_; share = share_; }
    __host__ __device__ bool next(int i, Unit& u) const {
        if (!share || so.G != 256 || so.nwg != 384) return so.next(i, u);
        if (i >= 2) return false;
        const bool even = !(c & 8); const int j = ((c >> 4) << 3) | (c & 7);
        const bool whole = even ? (i == 0) : (i == 1);
        so.decode(whole ? c : 256 + j, u);
        if (!whole) { u.nt = so.ntk / 2; u.koff = even ? 0 : (so.ntk / 2) * BK; u.role = even ? 2 : 1; u.sj = j; }
        return true;
    }
    __device__ __forceinline__ void a_ready(const Unit&) const {}
    __device__ __forceinline__ void done(const Unit&) const {}
};
__device__ __forceinline__ unsigned cvt_pk_bf16(float lo, float hi) { unsigned r; asm volatile("v_cvt_pk_bf16_f32 %0, %1, %2" : "=v"(r) : "v"(lo), "v"(hi)); return r; }
typedef float f32x2 __attribute__((ext_vector_type(2)));
template <int ACT, int MODE = 0> struct EpiBf16 {
    static constexpr bool PERM = true, AFTER_DRAIN = false;
    bf16_t* O; int ldc; bf16_t* V2; float* F2;
    __device__ __forceinline__ void operator()(const f32x4 (&acc)[2][2][4][2], const Unit& u, int wr, int wc, int fr, int fq) const {
        const int row0 = u.pm * BM + wr * 64 + fr; const int col0 = u.pn * BM + wc * 32 + 8 * fq;
        const bool redirect = (MODE == 2) ? (u.pn >= 8 && u.pn < 12) : (MODE == 3) ? (u.pn >= 10) : false;
        const int koff = (u.pm < 32) ? 0 : (((u.pm - 32) >> 2) * 512 + 512);
        const int vp = (MODE == 2) ? 1024 : 512;
        const int vc0 = (MODE == 2) ? (u.pn - 8) * 256 + wc * 32 + 8 * fq : (u.pn - 10) * 256 + wc * 32 + 8 * fq;
#pragma unroll
        for (int ai = 0; ai < 2; ++ai)
#pragma unroll
            for (int m = 0; m < 4; ++m) { const int row = row0 + ai * HALF + m * 16; bf16_t* rowp = O + (size_t)row * ldc + col0;
#pragma unroll
                for (int bj = 0; bj < 2; ++bj) { f32x4 v0 = acc[ai][bj][m][0], v1 = acc[ai][bj][m][1];
                    if (ACT == 1) {
#pragma unroll
                        for (int e = 0; e < 4; ++e) { float a = v0[e] > 0.f ? v0[e] : 0.f; v0[e] = a * a; float b = v1[e] > 0.f ? v1[e] : 0.f; v1[e] = b * b; }
                    }
                    u32x4 w; w.x = cvt_pk_bf16(v0[0], v0[1]); w.y = cvt_pk_bf16(v0[2], v0[3]); w.z = cvt_pk_bf16(v1[0], v1[1]); w.w = cvt_pk_bf16(v1[2], v1[3]);
                    if (MODE == 1 && bj == 1) { *(u32x4*)(V2 + (size_t)row * 1024 + u.pn * 128 + wc * 32 + 8 * fq) = w; }
                    else if ((MODE == 2 || MODE == 3) && redirect) {
                        *(u32x4*)(V2 + (size_t)(row + koff) * vp + vc0 + bj * HALF) = w;
                        if (u.pm < 32) { float* fp = F2 + (size_t)row * vp + vc0 + bj * HALF; *(f32x4*)fp = v0; *(f32x4*)(fp + 4) = v1; }
                    }
                    else *(u32x4*)(rowp + bj * HALF) = w; } }
    }
};
struct EpiResid {
    static constexpr bool PERM = true, AFTER_DRAIN = false;
    const float* xin_p; const float* xin_s; float* out; const float* gate; f32x4* part; unsigned* flags;
    __device__ __forceinline__ void operator()(const f32x4 (&acc)[2][2][4][2], const Unit& u, int wr, int wc, int fr, int fq) const {
        const int tid = threadIdx.x;
        if (u.role == 1) {
            const __amdgpu_buffer_rsrc_t rs = __builtin_amdgcn_make_buffer_rsrc((void*)part, 0, 32 << 20, 0x00020000);
            const unsigned boff = (unsigned)(u.sj * 16384 + tid) * 16u;
#pragma unroll
            for (int ai = 0; ai < 2; ++ai)
#pragma unroll
                for (int bj = 0; bj < 2; ++bj)
#pragma unroll
                    for (int m = 0; m < 4; ++m)
#pragma unroll
                        for (int n = 0; n < 2; ++n) __builtin_amdgcn_raw_buffer_store_b128(__builtin_bit_cast(u32x4, acc[ai][bj][m][n]), rs, boff + (unsigned)((((ai * 2 + bj) * 4 + m) * 2 + n) * 512 * 16), 0, 16);
            asm volatile("s_waitcnt vmcnt(0)" ::: "memory");
            __syncthreads();
            if (tid == 0) __hip_atomic_store(flags + u.sj, 1u, __ATOMIC_RELAXED, __HIP_MEMORY_SCOPE_AGENT);
            return;
        }
        const bool red = u.role == 2;
        if (red) {
            if (tid == 0) { while (__hip_atomic_load(flags + u.sj, __ATOMIC_RELAXED, __HIP_MEMORY_SCOPE_AGENT) == 0u) __builtin_amdgcn_s_sleep(2);
                __builtin_amdgcn_fence(__ATOMIC_ACQUIRE, "agent"); }
            asm volatile("s_waitcnt vmcnt(0)" ::: "memory");
            __syncthreads();
        }
        const f32x4* p = part + (size_t)u.sj * 16384 + tid;
        const int row0 = u.pm * BM + wr * 64 + fr; const int col0 = u.pn * BM + wc * 32 + 8 * fq;
        const int cond = (u.pm < 32) ? 0 : 1 + ((u.pm - 32) >> 2);
        const float* xin = (u.pm < 32) ? xin_p : xin_s;
        const float* gp = gate + (size_t)cond * 12288 + col0;
        f32x4 gv[2][2];
#pragma unroll
        for (int bj = 0; bj < 2; ++bj)
#pragma unroll
            for (int n = 0; n < 2; ++n) gv[bj][n] = *(const f32x4*)(gp + bj * HALF + 4 * n);
#pragma unroll
        for (int ai = 0; ai < 2; ++ai)
#pragma unroll
            for (int m = 0; m < 4; ++m) { const size_t off = (size_t)(row0 + ai * HALF + m * 16) * 2048 + col0;
#pragma unroll
                for (int bj = 0; bj < 2; ++bj)
#pragma unroll
                    for (int n = 0; n < 2; ++n) { const f32x4 xv = *(const f32x4*)(xin + off + bj * HALF + 4 * n);
                        f32x4 av = acc[ai][bj][m][n];
                        if (red) av += p[(((ai * 2 + bj) * 4 + m) * 2 + n) * 512];
                        *(f32x4*)(out + off + bj * HALF + 4 * n) = xv + gv[bj][n] * av; } }
    }
};
template <class Epi, class Sched, bool ALIGN_EPI = false, bool SP2 = false>
__device__ __forceinline__ void gemm_phase(PG8_LAS unsigned char* lds, const Gemm g, const Sched& S, const Epi& E) {
    const int tid = threadIdx.x, wid = __builtin_amdgcn_readfirstlane(tid >> 6), lane = tid & 63, wr = wid >> 2, wc = wid & 3, fr = lane & 15, fq = lane >> 4;
    const int K = g.K;
    unsigned voffA[2], voffB[2];
#pragma unroll
    for (int i = 0; i < 2; ++i) { int R, C; stage_rc(tid * 16 + i * 8192, R, C); const int Rb = Epi::PERM ? ((R & ~31) + perm32(R & 31)) : R;
        voffA[i] = (unsigned)(R * K + C) * 2u; voffB[i] = (unsigned)(Rb * K + C) * 2u; }
    const size_t kstep = (size_t)(BK * 2);
    const size_t hstep = (size_t)HALF * K * 2;
    const size_t tstep = 2 * hstep;
    const unsigned ldsw = (unsigned)wid * 1024u;
    const int aoff = lds_byte(wr * 64 + fr, fq * 8), boff = lds_byte(wc * 32 + fr, fq * 8);
#define PG8_SA(b, h) (((b) * 2 + (h)) * HTB)
#define PG8_SB(b, h) ((4 + (b) * 2 + (h)) * HTB)
#define PG8_STAGE(bufoff, gbase, voff) do { _Pragma("unroll") for (int _i = 0; _i < 2; ++_i) \
        __builtin_amdgcn_global_load_lds((const unsigned*)((const char*)(gbase) + (voff)[_i]), (PG8_LAS unsigned*)(lds + (bufoff) + ldsw + _i * 8192), 16, 0, 0); } while (0)
#define PG8_LDA(dst, b, h) do { _Pragma("unroll") for (int m = 0; m < 4; ++m) _Pragma("unroll") for (int k = 0; k < 2; ++k) dst[m][k] = *(const PG8_LAS bf16x8*)(lds + PG8_SA(b, h) + aoff + m * 2048 + k * 1024); } while (0)
#define PG8_LDB(dst, b, h) do { _Pragma("unroll") for (int n = 0; n < 2; ++n) _Pragma("unroll") for (int k = 0; k < 2; ++k) dst[n][k] = *(const PG8_LAS bf16x8*)(lds + PG8_SB(b, h) + boff + n * 2048 + k * 1024); } while (0)
#define PG8_MMA(ai, bj, At, Bt) do { __builtin_amdgcn_s_setprio(1); _Pragma("unroll") for (int m = 0; m < 4; ++m) _Pragma("unroll") for (int n = 0; n < 2; ++n) _Pragma("unroll") for (int k = 0; k < 2; ++k) \
        acc[ai][bj][m][n] = __builtin_amdgcn_mfma_f32_16x16x32_bf16(Bt[n][k], At[m][k], acc[ai][bj][m][n], 0, 0, 0); __builtin_amdgcn_s_setprio(0); } while (0)
#define PG8_WAIT_V(n) asm volatile("s_waitcnt vmcnt(" #n ")" ::: "memory")
#define PG8_WAIT_L(n) asm volatile("s_waitcnt lgkmcnt(" #n ")" ::: "memory")
#define PG8_BAR __builtin_amdgcn_s_barrier()
#define PG8_SCHED __builtin_amdgcn_sched_barrier(0)
    Unit cur, nxt; int ui = 0;
    if (!S.next(0, cur)) return;
    f32x4 acc[2][2][4][2];
#pragma unroll
    for (int a = 0; a < 2; ++a)
#pragma unroll
        for (int b = 0; b < 2; ++b)
#pragma unroll
            for (int m = 0; m < 4; ++m)
#pragma unroll
                for (int n = 0; n < 2; ++n) acc[a][b][m][n] = (f32x4){0.f, 0.f, 0.f, 0.f};
    bf16x8 At[4][2], B0[2][2], B1[2][2];
    const char* cA = (const char*)g.A + (size_t)cur.pm * tstep + (size_t)cur.koff * 2; const char* cB = (const char*)g.Bt + (size_t)cur.pn * tstep + (size_t)cur.koff * 2;
    S.a_ready(cur);
    if constexpr (SP2) {
        PG8_STAGE(PG8_SB(0, 0), cB, voffB); PG8_STAGE(PG8_SB(0, 1), cB + hstep, voffB); PG8_STAGE(PG8_SA(0, 0), cA, voffA); PG8_STAGE(PG8_SA(0, 1), cA + hstep, voffA);
        if (wr == 1) PG8_BAR;
        PG8_WAIT_V(2); PG8_BAR;
        PG8_STAGE(PG8_SB(1, 0), cB + kstep, voffB); PG8_STAGE(PG8_SA(1, 0), cA + kstep, voffA); PG8_STAGE(PG8_SB(1, 1), cB + hstep + kstep, voffB);
        PG8_WAIT_V(6); PG8_BAR;
    } else {
        PG8_STAGE(PG8_SB(0, 0), cB, voffB); PG8_STAGE(PG8_SA(0, 0), cA, voffA); PG8_STAGE(PG8_SB(0, 1), cB + hstep, voffB); PG8_STAGE(PG8_SA(0, 1), cA + hstep, voffA);
        if (wr == 1) PG8_BAR;
        PG8_WAIT_V(4); PG8_BAR;
        PG8_STAGE(PG8_SB(1, 0), cB + kstep, voffB); PG8_STAGE(PG8_SA(1, 0), cA + kstep, voffA); PG8_STAGE(PG8_SB(1, 1), cB + hstep + kstep, voffB);
        PG8_WAIT_V(6); PG8_BAR;
    }
    for (;;) {
        const bool has_next = S.next(ui + 1, nxt);
        const char* nA = has_next ? (const char*)g.A + (size_t)nxt.pm * tstep + (size_t)nxt.koff * 2 : cA; const char* nB = has_next ? (const char*)g.Bt + (size_t)nxt.pn * tstep + (size_t)nxt.koff * 2 : cB;
        const int nt = cur.nt;
        for (int t = 0; t < nt; t += 2) {
            const bool last = (t == nt - 2);
            const char* a1 = cA + (size_t)(t + 1) * kstep;
            const char* a2 = last ? nA : cA + (size_t)(t + 2) * kstep; const char* b2 = last ? nB : cB + (size_t)(t + 2) * kstep;
            const char* a3 = a2 + kstep; const char* b3 = b2 + kstep;
            if (last && has_next) S.a_ready(nxt);
            if constexpr (SP2) {
            PG8_LDB(B0, 0, 0); PG8_LDB(B1, 0, 1); PG8_SCHED; PG8_LDA(At, 0, 0); PG8_STAGE(PG8_SA(1, 1), a1 + hstep, voffA);
            PG8_WAIT_V(8); PG8_WAIT_L(0); PG8_BAR; PG8_MMA(0, 0, At, B0); PG8_MMA(0, 1, At, B1); PG8_BAR; PG8_SCHED;
            PG8_LDA(At, 0, 1); PG8_STAGE(PG8_SB(0, 0), b2, voffB); PG8_STAGE(PG8_SB(0, 1), b2 + hstep, voffB); PG8_STAGE(PG8_SA(0, 0), a2, voffA);
            PG8_WAIT_V(8); PG8_WAIT_L(0); PG8_BAR; PG8_MMA(1, 0, At, B0); PG8_MMA(1, 1, At, B1); PG8_BAR; PG8_SCHED;
            PG8_LDB(B0, 1, 0); PG8_LDB(B1, 1, 1); PG8_SCHED; PG8_LDA(At, 1, 0); PG8_STAGE(PG8_SA(0, 1), a2 + hstep, voffA);
            PG8_WAIT_V(8); PG8_WAIT_L(0); PG8_BAR; PG8_MMA(0, 0, At, B0); PG8_MMA(0, 1, At, B1); PG8_BAR; PG8_SCHED;
            PG8_LDA(At, 1, 1); PG8_STAGE(PG8_SB(1, 0), b3, voffB); PG8_STAGE(PG8_SB(1, 1), b3 + hstep, voffB); PG8_STAGE(PG8_SA(1, 0), a3, voffA);
            PG8_WAIT_V(8); PG8_WAIT_L(0); PG8_BAR; PG8_MMA(1, 0, At, B0); PG8_MMA(1, 1, At, B1); PG8_BAR; PG8_SCHED;
            } else {
            PG8_LDB(B0, 0, 0); PG8_SCHED; PG8_LDA(At, 0, 0); PG8_STAGE(PG8_SA(1, 1), a1 + hstep, voffA);
            PG8_WAIT_L(8); PG8_BAR; PG8_WAIT_L(0); PG8_MMA(0, 0, At, B0); PG8_BAR; PG8_SCHED;
            PG8_LDB(B1, 0, 1); PG8_STAGE(PG8_SB(0, 0), b2, voffB);
            PG8_BAR; PG8_WAIT_L(0); PG8_MMA(0, 1, At, B1); PG8_BAR;
            PG8_LDA(At, 0, 1); PG8_STAGE(PG8_SA(0, 0), a2, voffA);
            PG8_BAR; PG8_WAIT_L(0); PG8_MMA(1, 0, At, B0); PG8_BAR; PG8_SCHED;
            PG8_STAGE(PG8_SB(0, 1), b2 + hstep, voffB);
            PG8_WAIT_V(6); PG8_BAR; PG8_MMA(1, 1, At, B1); PG8_BAR;
            PG8_LDB(B0, 1, 0); PG8_SCHED; PG8_LDA(At, 1, 0); PG8_STAGE(PG8_SA(0, 1), a2 + hstep, voffA);
            PG8_WAIT_L(8); PG8_BAR; PG8_WAIT_L(0); PG8_MMA(0, 0, At, B0); PG8_BAR; PG8_SCHED;
            PG8_LDB(B1, 1, 1); PG8_STAGE(PG8_SB(1, 0), b3, voffB);
            PG8_BAR; PG8_WAIT_L(0); PG8_MMA(0, 1, At, B1); PG8_BAR;
            PG8_LDA(At, 1, 1); PG8_STAGE(PG8_SA(1, 0), a3, voffA);
            PG8_BAR; PG8_WAIT_L(0); PG8_MMA(1, 0, At, B0); PG8_BAR; PG8_SCHED;
            PG8_STAGE(PG8_SB(1, 1), b3 + hstep, voffB);
            PG8_WAIT_V(6); PG8_BAR; PG8_MMA(1, 1, At, B1); PG8_BAR;
            }
        }
        if constexpr (ALIGN_EPI) { if (wr == 0) PG8_BAR; }
        if constexpr (!Epi::AFTER_DRAIN) { E(acc, cur, wr, wc, fr, fq); S.done(cur); }
        if (!has_next) break;
#pragma unroll
        for (int a = 0; a < 2; ++a)
#pragma unroll
            for (int b = 0; b < 2; ++b)
#pragma unroll
                for (int m = 0; m < 4; ++m)
#pragma unroll
                    for (int n = 0; n < 2; ++n) acc[a][b][m][n] = (f32x4){0.f, 0.f, 0.f, 0.f};
        cur = nxt; cA = nA; cB = nB; ++ui;
        if constexpr (ALIGN_EPI) { if (wr == 1) PG8_BAR; }
    }
    PG8_WAIT_V(0);
    if constexpr (!ALIGN_EPI) { if (wr == 0) PG8_BAR; }
    PG8_BAR;
    if constexpr (Epi::AFTER_DRAIN) { E.fused(acc, cur, wr, wc, fr, fq, lds, wid, lane); S.done(cur); }
#undef PG8_SA
#undef PG8_SB
#undef PG8_STAGE
#undef PG8_LDA
#undef PG8_LDB
#undef PG8_MMA
#undef PG8_WAIT_V
#undef PG8_WAIT_L
#undef PG8_BAR
#undef PG8_SCHED
}
}
#define LAS __attribute__((address_space(3)))
typedef unsigned short bf16;
typedef short bf16x8 __attribute__((ext_vector_type(8)));
typedef short s16x4 __attribute__((ext_vector_type(4)));
typedef float f32x4 __attribute__((ext_vector_type(4)));
typedef float f32x16 __attribute__((ext_vector_type(16)));
typedef unsigned u32x4 __attribute__((ext_vector_type(4)));
typedef unsigned u32x2 __attribute__((ext_vector_type(2)));
#define DI __device__ __forceinline__
#define MFMA32(a, b, c) __builtin_amdgcn_mfma_f32_32x32x16_bf16((a), (b), (c), 0, 0, 0)

DI unsigned f2bf(float f) { unsigned u = __builtin_bit_cast(unsigned, f); return (u + 0x7fffu + ((u >> 16) & 1u)) >> 16; }
typedef __bf16 bf16x2_t __attribute__((ext_vector_type(2)));
typedef float f32x2_t __attribute__((ext_vector_type(2)));
DI unsigned pk2(float lo, float hi) { const f32x2_t v = {lo, hi}; const bf16x2_t b = __builtin_convertvector(v, bf16x2_t); return __builtin_bit_cast(unsigned, b); }
DI float bflo(unsigned w) { return __builtin_bit_cast(float, w << 16); }
DI float bfhi(unsigned w) { return __builtin_bit_cast(float, w & 0xffff0000u); }
DI float wave_sum(float v) {
#pragma unroll
    for (int o = 1; o < 64; o <<= 1) v += __shfl_xor(v, o);
    return v;
}

constexpr int DM = 2048, NPT = 8192, NTOK = 12288, NKV = 14336, FFD = 8192, ABP = 4352;
constexpr float EPSF = 1e-6f, LOG2E = 1.4426950408889634f;
constexpr int NWAVES = 8, NTHR = 512;
constexpr size_t MiB = 1u << 20;
constexpr size_t WS_WIN0 = 0;
constexpr size_t WS_WQUP = 17 * MiB;
constexpr size_t WS_WKVUP = WS_WQUP + 1536 * 512 * 2;
constexpr size_t WS_WOUT0 = WS_WKVUP + 2048 * 512 * 2;
constexpr size_t WS_WFF1 = WS_WOUT0 + 8 * MiB;
constexpr size_t WS_WFF2 = WS_WFF1 + 64 * MiB;
constexpr size_t WS_WCIN = WS_WFF2 + 64 * MiB;
constexpr size_t WS_WCOUT = WS_WCIN + 12 * MiB;
constexpr size_t WS_MOD = WS_WCOUT + 8 * MiB;
constexpr size_t WS_TAB = WS_MOD + 512 * 1024;
constexpr size_t WS_XA = WS_TAB + 512 * 1024;
constexpr size_t WS_XB = WS_XA + 96 * MiB;
constexpr size_t WS_H = WS_XB + 96 * MiB;
constexpr size_t WS_R = WS_H + 48 * MiB;
constexpr size_t WS_RAW = WS_R;
constexpr size_t WS_RAW2 = WS_R;
constexpr size_t WS_RAW3 = WS_R + 36 * MiB;
constexpr size_t WS_QDA = WS_R + 102 * MiB;
constexpr size_t WS_KDA = WS_QDA + 24 * MiB;
constexpr size_t WS_VDA = WS_KDA + 28 * MiB;
constexpr size_t WS_MQN = WS_VDA + 28 * MiB;
constexpr size_t WS_CKV = WS_MQN + 12 * MiB;
constexpr size_t WS_VMLA = WS_CKV + 14 * MiB;
constexpr size_t WS_KR = WS_VMLA + 28 * MiB;
constexpr size_t WS_PART = WS_KR + 4 * MiB;
constexpr size_t WS_FLAGS = WS_PART + 32 * MiB;
constexpr size_t WS_BAR = WS_FLAGS + 64 * 1024;
constexpr size_t WS_END = WS_FLAGS + 1 * MiB;
constexpr size_t WS_QMLA = WS_XB;
constexpr size_t WS_KMLA = WS_XB + 36 * MiB;
constexpr size_t WS_FFH = WS_R;
constexpr size_t WS_RAWC = WS_R;
constexpr size_t WS_QC = WS_R + 72 * MiB;
constexpr size_t WS_KC = WS_QC + 48 * MiB;
constexpr size_t WS_VC = WS_KC + 14 * MiB;
static_assert(WS_END <= 768 * MiB && WS_FFH + 192 * MiB <= WS_END, "ws map");
constexpr int TB_C16 = 0, TB_S16 = 1024, TB_C32 = 2048, TB_S32 = 4096, TB_LAM = 6144;
constexpr size_t OUT_Y = 0, OUT_DAK = 25165824, OUT_DAV = 33554432, OUT_CKV = 41943040, OUT_KR = 46137344, OUT_GQK = 46661632, OUT_GQV = 50855936;
constexpr int LDS_BYTES = 147456;

struct Args { const float* in[36]; float* out; unsigned char* ws; int ph_lo, ph_hi, coop, pad; };

DI int kvrow_of(int r) { if (r < NPT) return r; const int s = r - NPT; return NPT + (s >> 10) * 1536 + 512 + (s & 1023); }

struct TrDesc { const float* W; bf16* WT; int K, N, item; };
DI void tr_load(const TrDesc& d, f32x4 (&v)[4], int tid) {
    const int nblk = d.N / 64, kb = d.item / nblk, nb = d.item % nblk, k0 = kb * 128, n0 = nb * 64;
    const int kr = tid >> 4, nc = (tid & 15) * 4;
#pragma unroll
    for (int p = 0; p < 4; ++p) v[p] = __builtin_nontemporal_load((const f32x4*)(d.W + (size_t)(k0 + kr + 32 * p) * d.N + n0 + nc));
}
DI void tr_store(const TrDesc& d, const f32x4 (&v)[4], LAS float* T, int tid) {
    const int nblk = d.N / 64, kb = d.item / nblk, nb = d.item % nblk, k0 = kb * 128, n0 = nb * 64;
    const int kr = tid >> 4, nc = (tid & 15) * 4;
#pragma unroll
    for (int p = 0; p < 4; ++p) { const int k = kr + 32 * p; T[k * 65 + nc] = v[p].x; T[k * 65 + nc + 1] = v[p].y; T[k * 65 + nc + 2] = v[p].z; T[k * 65 + nc + 3] = v[p].w; }
    __syncthreads();
#pragma unroll
    for (int i = 0; i < 2; ++i) { const int it = tid + 512 * i, kc = it & 15, n = it >> 4; const LAS float* s = T + (kc * 8) * 65 + n;
        u32x4 o; o.x = pk2(s[0], s[65]); o.y = pk2(s[130], s[195]); o.z = pk2(s[260], s[325]); o.w = pk2(s[390], s[455]);
        *(u32x4*)(d.WT + (size_t)(n0 + n) * d.K + k0 + kc * 8) = o; }
}

DI void ada_unit(const Args& a, int l, int u, LAS float* L, int tid) {
    const int col0 = u * 48;
    LAS float* S = L; LAS float* RED = L + 5 * 2048;
    for (int i = tid; i < 5 * 2048; i += NTHR) { const int c = i >> 11, k = i & 2047; const float v = (c == 0) ? a.in[9][k] : a.in[8][(c - 1) * 2048 + k]; S[i] = v / (1.f + __expf(-v)); }
    __syncthreads();
    const int c4 = tid % 12, kg = tid / 12;
    if (kg < 32) {
        float acc[5][4];
#pragma unroll
        for (int c = 0; c < 5; ++c)
#pragma unroll
            for (int j = 0; j < 4; ++j) acc[c][j] = 0.f;
        const float* wp = a.in[12] + (size_t)l * 2048 * 12288 + (size_t)(kg * 64) * 12288 + col0 + c4 * 4;
#pragma unroll 1
        for (int k0 = 0; k0 < 64; k0 += 16) {
            f32x4 w[16];
#pragma unroll
            for (int kk = 0; kk < 16; ++kk) w[kk] = __builtin_nontemporal_load((const f32x4*)(wp + (size_t)(k0 + kk) * 12288));
#pragma unroll
            for (int kk = 0; kk < 16; ++kk)
#pragma unroll
                for (int c = 0; c < 5; ++c) { const float s = S[c * 2048 + kg * 64 + k0 + kk];
#pragma unroll
                    for (int j = 0; j < 4; ++j) acc[c][j] += s * w[kk][j]; }
        }
#pragma unroll
        for (int c = 0; c < 5; ++c)
#pragma unroll
            for (int j = 0; j < 4; ++j) RED[(kg * 5 + c) * 48 + c4 * 4 + j] = acc[c][j];
    }
    __syncthreads();
    float* MOD = (float*)(a.ws + WS_MOD);
    if (tid < 240) { const int c = tid / 48, col = tid % 48; float s = 0.f;
#pragma unroll
        for (int g = 0; g < 32; ++g) s += RED[(g * 5 + c) * 48 + col];
        MOD[(size_t)(l * 5 + c) * 12288 + col0 + col] = s + a.in[13][l * 12288 + col0 + col]; }
    __syncthreads();
}

DI void misc_unit(const Args& a, int tid) {
    float* TB = (float*)(a.ws + WS_TAB);
    for (int idx = tid; idx < 64 * 16 + 64 * 32; idx += NTHR) {
        int half, pos, i, oc, os;
        if (idx < 1024) { half = 16; pos = idx >> 4; i = idx & 15; oc = TB_C16 + idx; os = TB_S16 + idx; }
        else { const int j = idx - 1024; half = 32; pos = j >> 5; i = j & 31; oc = TB_C32 + j; os = TB_S32 + j; }
        const float inv = exp2f(-((float)i / (float)half) * 13.287712379549449f);
        const float ang = (float)pos * inv;
        const float n = rintf(ang * 0.15915494309189535f);
        float r = fmaf(-n, 6.2831854820251465f, ang); r = fmaf(n, 1.7484556000744883e-07f, r);
        TB[oc] = __cosf(r); TB[os] = __sinf(r);
    }
    if (tid == 0) { float s1 = 0.f, s2 = 0.f;
        for (int i = 0; i < 64; ++i) { s1 += a.in[18][i] * a.in[19][i]; s2 += a.in[20][i] * a.in[21][i]; }
        TB[TB_LAM] = expf(s1) - expf(s2) + 0.2f; }
}

constexpr int CI_A = 1264, CI_B = 5248, CI_C = 7664, CI_END = 11248;
DI TrDesc tr_decode(const Args& a, int r) {
    unsigned char* ws = a.ws;
    if (r < 1040) return TrDesc{a.in[16], (bf16*)(ws + WS_WIN0), 2048, 4160, r}; r -= 1040;
    if (r < 96) return TrDesc{a.in[26], (bf16*)(ws + WS_WQUP), 512, 1536, r}; r -= 96;
    if (r < 128) return TrDesc{a.in[28], (bf16*)(ws + WS_WKVUP), 512, 2048, r}; r -= 128;
    if (r < 2048) return TrDesc{a.in[14], (bf16*)(ws + WS_WFF1), 2048, 8192, r}; r -= 2048;
    if (r < 512) return TrDesc{a.in[17], (bf16*)(ws + WS_WOUT0), 2048, 2048, r}; r -= 512;
    if (r < 1024) return TrDesc{a.in[15] + (size_t)2048 * 8192, (bf16*)(ws + WS_WFF2) + (size_t)8192 * 2048, 8192, 2048, r}; r -= 1024;
    if (r < 400) return TrDesc{a.in[31], (bf16*)(ws + WS_WCIN), 2048, 3072, r}; r -= 400;
    if (r < 2048) return TrDesc{a.in[15], (bf16*)(ws + WS_WFF2), 8192, 2048, r}; r -= 2048;
    if (r < 368) return TrDesc{a.in[31], (bf16*)(ws + WS_WCIN), 2048, 3072, r + 400}; r -= 368;
    if (r < 512) return TrDesc{a.in[32], (bf16*)(ws + WS_WCOUT), 2048, 2048, r}; r -= 512;
    if (r < 2048) return TrDesc{a.in[14] + (size_t)2048 * 8192, (bf16*)(ws + WS_WFF1) + (size_t)8192 * 2048, 2048, 8192, r}; r -= 2048;
    return TrDesc{a.in[15] + (size_t)2048 * 8192, (bf16*)(ws + WS_WFF2) + (size_t)8192 * 2048, 8192, 2048, r + 1024};
}
DI void convert_items(const Args& a, LAS unsigned char* lds, int tid, int first, int stride, int lo, int hi) {
    LAS float* L = (LAS float*)lds;
    int it = lo + first, par = 0;
    if (it >= hi) return;
    __syncthreads();
    TrDesc cur = tr_decode(a, it);
    f32x4 v[4];
    tr_load(cur, v, tid);
    for (; it < hi; it += stride) {
        const int nit = it + stride;
        TrDesc nxt = cur; f32x4 nv[4];
        if (nit < hi) { nxt = tr_decode(a, nit); tr_load(nxt, nv, tid); }
        tr_store(cur, v, L + par * (128 * 65), tid); par ^= 1;
        if (nit < hi) { cur = nxt;
#pragma unroll
            for (int p = 0; p < 4; ++p) v[p] = nv[p]; }
    }
    __syncthreads();
}
DI void bg_convert(const Args& a, LAS unsigned char* lds, int tid, int G, int nwg, int lo, int hi) {
    const int rem = nwg % G, c = (int)blockIdx.x;
    if (rem == 0) convert_items(a, lds, tid, c, G, lo, hi);
    else if (c >= rem) convert_items(a, lds, tid, c - rem, G - rem, lo, hi);
}
DI void phase0(const Args& a, LAS unsigned char* lds, int tid, int G) {
    LAS float* L = (LAS float*)lds;
    const int c = (int)blockIdx.x;
    if (c == 0) { ((unsigned*)(a.ws + WS_FLAGS))[tid] = 0u; for (int i = tid; i < 3456; i += NTHR) ((unsigned*)(a.ws + WS_BAR))[i] = 0u; }
    convert_items(a, lds, tid, c, G, 0, CI_A);
    for (int it = c; it < 513; it += G) { if (it < 512) ada_unit(a, it >> 8, it & 255, L, tid); else misc_unit(a, tid); }
}
DI void bg_ada1(const Args& a, LAS unsigned char* lds, int tid, int G, int nwg) {
    const int rem = nwg % G, c = (int)blockIdx.x;
    const int first = rem == 0 ? c : c - rem, stride = rem == 0 ? G : G - rem;
    if (first < 0) return;
    for (int it = first; it < 256; it += stride) ada_unit(a, 1, it, (LAS float*)lds, tid);
}

DI void norm_phase(const float* xp, const float* xs  , const float* g, const float* mod_l  , int sh_off, int sc_off, bf16* H, int tid, int G) {
    const int lane = tid & 63, wave = tid >> 6;
    f32x4 gg[8];
#pragma unroll
    for (int j = 0; j < 8; ++j) gg[j] = *(const f32x4*)(g + 4 * lane + 256 * j);
    for (int row = blockIdx.x * NWAVES + wave; row < NTOK; row += G * NWAVES) {
        const float* x = (row < NPT ? xp : xs) + (size_t)row * DM;
        const int cond = row < NPT ? 0 : 1 + ((row - NPT) >> 10);
        const float* md = mod_l + (size_t)cond * 12288;
        f32x4 v[8], sc[8], sh[8]; float ss = 0.f;
#pragma unroll
        for (int j = 0; j < 8; ++j) v[j] = *(const f32x4*)(x + 4 * lane + 256 * j);
#pragma unroll
        for (int j = 0; j < 8; ++j) { sc[j] = *(const f32x4*)(md + sc_off + 4 * lane + 256 * j); sh[j] = *(const f32x4*)(md + sh_off + 4 * lane + 256 * j); }
#pragma unroll
        for (int j = 0; j < 8; ++j) ss += v[j].x * v[j].x + v[j].y * v[j].y + v[j].z * v[j].z + v[j].w * v[j].w;
        ss = wave_sum(ss);
        const float rs = rsqrtf(ss * (1.f / DM) + EPSF);
#pragma unroll
        for (int j = 0; j < 8; ++j) { const int col = 4 * lane + 256 * j;
            const f32x4 y = v[j] * rs * gg[j] * (sc[j] + 1.f) + sh[j];
            u32x2 o; o.x = pk2(y.x, y.y); o.y = pk2(y.z, y.w);
            *(u32x2*)(H + (size_t)row * DM + col) = o; }
    }
}
DI void ld16(const bf16* p, float (&v)[16]) {
    const u32x4 w0 = *(const u32x4*)p, w1 = *(const u32x4*)(p + 8);
    v[0] = bflo(w0.x); v[1] = bfhi(w0.x); v[2] = bflo(w0.y); v[3] = bfhi(w0.y); v[4] = bflo(w0.z); v[5] = bfhi(w0.z); v[6] = bflo(w0.w); v[7] = bfhi(w0.w);
    v[8] = bflo(w1.x); v[9] = bfhi(w1.x); v[10] = bflo(w1.y); v[11] = bfhi(w1.y); v[12] = bflo(w1.z); v[13] = bfhi(w1.z); v[14] = bflo(w1.w); v[15] = bfhi(w1.w);
}
DI void ld8(const bf16* p, float (&v)[8]) {
    const u32x4 w0 = *(const u32x4*)p;
    v[0] = bflo(w0.x); v[1] = bfhi(w0.x); v[2] = bflo(w0.y); v[3] = bfhi(w0.y); v[4] = bflo(w0.z); v[5] = bfhi(w0.z); v[6] = bflo(w0.w); v[7] = bfhi(w0.w);
}
DI void st16bf(bf16* p, const float (&v)[16]) {
    u32x4 w0, w1; w0.x = pk2(v[0], v[1]); w0.y = pk2(v[2], v[3]); w0.z = pk2(v[4], v[5]); w0.w = pk2(v[6], v[7]);
    w1.x = pk2(v[8], v[9]); w1.y = pk2(v[10], v[11]); w1.z = pk2(v[12], v[13]); w1.w = pk2(v[14], v[15]);
    *(u32x4*)p = w0; *(u32x4*)(p + 8) = w1;
}
DI void st8bf(bf16* p, const float (&v)[8]) {
    u32x4 w0; w0.x = pk2(v[0], v[1]); w0.y = pk2(v[2], v[3]); w0.z = pk2(v[4], v[5]); w0.w = pk2(v[6], v[7]);
    *(u32x4*)p = w0;
}
DI void st16f(float* p, const float (&v)[16]) {
#pragma unroll
    for (int j = 0; j < 4; ++j) *(f32x4*)(p + 4 * j) = (f32x4){v[4 * j], v[4 * j + 1], v[4 * j + 2], v[4 * j + 3]};
}
DI void st8f(float* p, const float (&v)[8]) {
    *(f32x4*)p = (f32x4){v[0], v[1], v[2], v[3]}; *(f32x4*)(p + 4) = (f32x4){v[4], v[5], v[6], v[7]};
}
DI void ld8f(const float* p, float (&v)[8]) { const f32x4 a = *(const f32x4*)p, b = *(const f32x4*)(p + 4); v[0] = a.x; v[1] = a.y; v[2] = a.z; v[3] = a.w; v[4] = b.x; v[5] = b.y; v[6] = b.z; v[7] = b.w; }
DI void ld16f(const float* p, float (&v)[16]) {
#pragma unroll
    for (int j = 0; j < 4; ++j) { const f32x4 a = *(const f32x4*)(p + 4 * j); v[4 * j] = a.x; v[4 * j + 1] = a.y; v[4 * j + 2] = a.z; v[4 * j + 3] = a.w; }
}
DI void cv16(const u32x4& w0, const u32x4& w1, float (&v)[16]) {
    v[0] = bflo(w0.x); v[1] = bfhi(w0.x); v[2] = bflo(w0.y); v[3] = bfhi(w0.y); v[4] = bflo(w0.z); v[5] = bfhi(w0.z); v[6] = bflo(w0.w); v[7] = bfhi(w0.w);
    v[8] = bflo(w1.x); v[9] = bfhi(w1.x); v[10] = bflo(w1.y); v[11] = bfhi(w1.y); v[12] = bflo(w1.z); v[13] = bfhi(w1.z); v[14] = bflo(w1.w); v[15] = bfhi(w1.w);
}
DI void cv8(const u32x4& w0, float (&v)[8]) {
    v[0] = bflo(w0.x); v[1] = bfhi(w0.x); v[2] = bflo(w0.y); v[3] = bfhi(w0.y); v[4] = bflo(w0.z); v[5] = bfhi(w0.z); v[6] = bflo(w0.w); v[7] = bfhi(w0.w);
}
template <int N> DI void rope_apply(float (&y)[N], int px, const float (&tc)[N], const float (&ts)[N], bool is_x2, bool active) {
#pragma unroll
    for (int j = 0; j < N; ++j) { const float py = __shfl_xor(y[j], px); if (active) { const float c = tc[j], s = ts[j]; y[j] = is_x2 ? y[j] * c + py * s : y[j] * c - py * s; } }
}

DI void postA_phase(const Args& a, int tid, int G) {
    unsigned char* ws = a.ws;
    const bf16* RAW = (const bf16*)(ws + WS_RAW);
    bf16 *QDA = (bf16*)(ws + WS_QDA), *KDA = (bf16*)(ws + WS_KDA), *VDA = (bf16*)(ws + WS_VDA), *MQN = (bf16*)(ws + WS_MQN), *CKV = (bf16*)(ws + WS_CKV);
    float* KR = (float*)(ws + WS_KR); const float* TB = (const float*)(ws + WS_TAB);
    const int lane = tid & 63, wave = tid >> 6;
    const int sub = lane & 3;
    float gq[16], gk[16], gmq[8], gmkv[8];
    ld16f(a.in[22] + 16 * sub, gq); ld16f(a.in[23] + 16 * sub, gk); ld8f(a.in[25] + 8 * lane, gmq); ld8f(a.in[27] + 8 * lane, gmkv);
    for (int r = blockIdx.x * NWAVES + wave; r < NTOK + 2048; r += G * NWAVES) {
        if (r < NTOK) {
            const bool isS = r >= NPT; const int t = (r - NPT) & 1023; const int prow = t >> 6, pcol = t & 63;
            const int kvr = kvrow_of(r);
            const bf16* raw = RAW + (size_t)r * ABP;
            const int pos = (sub < 2) ? prow : pcol;
            float tc[16], ts[16];
            if (isS) { ld16f(TB + TB_C16 + pos * 16, tc); ld16f(TB + TB_S16 + pos * 16, ts); }
            else {
#pragma unroll
                for (int j = 0; j < 16; ++j) { tc[j] = 1.f; ts[j] = 0.f; } }
            float v[16];
            const u32x4 rq0 = *(const u32x4*)(raw + 16 * lane), rq1 = *(const u32x4*)(raw + 16 * lane + 8);
            const u32x4 rk0 = *(const u32x4*)(raw + 1024 + 16 * lane), rk1 = *(const u32x4*)(raw + 1024 + 16 * lane + 8);
            const u32x4 rmq = *(const u32x4*)(raw + 3072 + 8 * lane), rmkv = *(const u32x4*)(raw + 3584 + 8 * lane);
            const unsigned short rkr = raw[4096 + lane];
            cv16(rq0, rq1, v);
            { float ss = 0.f;
#pragma unroll
              for (int j = 0; j < 16; ++j) ss += v[j] * v[j];
              ss += __shfl_xor(ss, 1); ss += __shfl_xor(ss, 2); const float rs = rsqrtf(ss * (1.f / 64.f) + EPSF);
#pragma unroll
              for (int j = 0; j < 16; ++j) v[j] = v[j] * rs * gq[j]; }
            rope_apply<16>(v, 1, tc, ts, (sub & 1) != 0, isS);
            st16bf(QDA + (size_t)r * 1024 + 16 * lane, v);
            cv16(rk0, rk1, v);
            { float ss = 0.f;
#pragma unroll
              for (int j = 0; j < 16; ++j) ss += v[j] * v[j];
              ss += __shfl_xor(ss, 1); ss += __shfl_xor(ss, 2); const float rs = rsqrtf(ss * (1.f / 64.f) + EPSF);
#pragma unroll
              for (int j = 0; j < 16; ++j) v[j] = v[j] * rs * gk[j]; }
            if (!isS) st16f(a.out + OUT_DAK + (size_t)r * 1024 + 16 * lane, v);
            rope_apply<16>(v, 1, tc, ts, (sub & 1) != 0, isS);
            st16bf(KDA + (size_t)kvr * 1024 + 16 * lane, v);
            float w[8];
            cv8(rmq, w);
            { float ss = 0.f;
#pragma unroll
              for (int j = 0; j < 8; ++j) ss += w[j] * w[j];
              ss = wave_sum(ss); const float rs = rsqrtf(ss * (1.f / 512.f) + EPSF);
#pragma unroll
              for (int j = 0; j < 8; ++j) w[j] = w[j] * rs * gmq[j]; }
            st8bf(MQN + (size_t)r * 512 + 8 * lane, w);
            cv8(rmkv, w);
            { float ss = 0.f;
#pragma unroll
              for (int j = 0; j < 8; ++j) ss += w[j] * w[j];
              ss = wave_sum(ss); const float rs = rsqrtf(ss * (1.f / 512.f) + EPSF);
#pragma unroll
              for (int j = 0; j < 8; ++j) w[j] = w[j] * rs * gmkv[j]; }
            st8bf(CKV + (size_t)kvr * 512 + 8 * lane, w);
            if (!isS) st8f(a.out + OUT_CKV + (size_t)r * 512 + 8 * lane, w);
            { const float kr = __builtin_bit_cast(float, (unsigned)rkr << 16);
              KR[(size_t)kvr * 64 + lane] = kr; if (!isS) a.out[OUT_KR + (size_t)r * 64 + lane] = kr; }
        } else {
            const int c = r - NTOK, b = c >> 9, p = c & 511; const int kvr = NPT + b * 1536 + p;
            float v[16], v2[16], w[8];
            ld16f(a.in[2] + (size_t)c * 1024 + 16 * lane, v); ld16f(a.in[3] + (size_t)c * 1024 + 16 * lane, v2); ld8f(a.in[4] + (size_t)c * 512 + 8 * lane, w);
            const float krv = a.in[5][(size_t)c * 64 + lane];
            st16bf(KDA + (size_t)kvr * 1024 + 16 * lane, v); st16bf(VDA + (size_t)kvr * 1024 + 16 * lane, v2);
            st8bf(CKV + (size_t)kvr * 512 + 8 * lane, w);
            KR[(size_t)kvr * 64 + lane] = krv;
        }
    }
}

DI void postB_phase(const Args& a, int tid, int G) {
    unsigned char* ws = a.ws;
    const bf16* RAW2 = (const bf16*)(ws + WS_RAW2); const bf16* RAW3 = (const bf16*)(ws + WS_RAW3);
    bf16 *QM = (bf16*)(ws + WS_QMLA), *KM = (bf16*)(ws + WS_KMLA), *VM = (bf16*)(ws + WS_VMLA);
    const float* KR = (const float*)(ws + WS_KR); const float* TB = (const float*)(ws + WS_TAB);
    const int lane = tid & 63, wave = tid >> 6, half = lane >> 5, li = lane & 31;
    const int cidx = li - 16;
    const bool ropelane = li >= 16 && li < 24;
    float gqn[8], gkn[8];
#pragma unroll
    for (int j = 0; j < 8; ++j) { gqn[j] = 0.f; gkn[j] = 0.f; }
    if (li < 24) { ld8f(a.in[29] + 8 * li, gqn); ld8f(a.in[30] + 8 * li, gkn); }
    for (int r = blockIdx.x * NWAVES + wave; r < NTOK + NKV; r += G * NWAVES) {
        if (r < NTOK) {
            const bool isS = r >= NPT; const int t = (r - NPT) & 1023; const int prow = t >> 6, pcol = t & 63;
            const int pos = (cidx < 4) ? prow : pcol;
            float tc[8], ts[8];
            if (isS) { ld8f(TB + TB_C16 + pos * 16 + 8 * (cidx & 1), tc); ld8f(TB + TB_S16 + pos * 16 + 8 * (cidx & 1), ts); }
            else {
#pragma unroll
                for (int j = 0; j < 8; ++j) { tc[j] = 1.f; ts[j] = 0.f; } }
            u32x4 rw[4];
#pragma unroll
            for (int it = 0; it < 4; ++it) { rw[it] = (u32x4){0u, 0u, 0u, 0u}; if (li < 24) rw[it] = *(const u32x4*)(RAW2 + (size_t)r * 1536 + (it * 2 + half) * 192 + 8 * li); }
#pragma unroll
            for (int it = 0; it < 4; ++it) { const int head = it * 2 + half;
                float w[8];
                cv8(rw[it], w);
                float ss = 0.f;
#pragma unroll
                for (int j = 0; j < 8; ++j) ss += w[j] * w[j];
#pragma unroll
                for (int o = 1; o < 32; o <<= 1) ss += __shfl_xor(ss, o);
                const float rs = rsqrtf(ss * (1.f / 192.f) + EPSF);
                if (li < 24) {
#pragma unroll
                    for (int j = 0; j < 8; ++j) w[j] = w[j] * rs * gqn[j]; }
                rope_apply<8>(w, 2, tc, ts, (cidx & 2) != 0, isS && ropelane);
                if (li < 24) st8bf(QM + (size_t)r * 1536 + head * 192 + 8 * li, w);
            }
        } else {
            const int kvr = r - NTOK;
            const int sj = (kvr - NPT) % 1536; const bool lat = kvr >= NPT && sj >= 512; const int t = sj - 512; const int prow = (t >> 6) & 15, pcol = t & 63;
            const int pos = (cidx < 4) ? prow : pcol;
            float tc[8], ts[8];
            if (lat) { ld8f(TB + TB_C16 + pos * 16 + 8 * (cidx & 1), tc); ld8f(TB + TB_S16 + pos * 16 + 8 * (cidx & 1), ts); }
            else {
#pragma unroll
                for (int j = 0; j < 8; ++j) { tc[j] = 1.f; ts[j] = 0.f; } }
            float kr[8];
#pragma unroll
            for (int j = 0; j < 8; ++j) kr[j] = 0.f;
            if (ropelane) ld8f(KR + (size_t)kvr * 64 + 8 * cidx, kr);
            u32x4 rk[4];
#pragma unroll
            for (int it = 0; it < 4; ++it) { rk[it] = (u32x4){0u, 0u, 0u, 0u};
                if (li < 16) rk[it] = *(const u32x4*)(RAW3 + (size_t)kvr * 2048 + (it * 2 + half) * 256 + 8 * li); }
#pragma unroll
            for (int it = 0; it < 4; ++it) { const int head = it * 2 + half;
                float w[8];
#pragma unroll
                for (int j = 0; j < 8; ++j) w[j] = kr[j];
                if (li < 16) cv8(rk[it], w);
                float ss = 0.f;
#pragma unroll
                for (int j = 0; j < 8; ++j) ss += w[j] * w[j];
#pragma unroll
                for (int o = 1; o < 32; o <<= 1) ss += __shfl_xor(ss, o);
                const float rs = rsqrtf(ss * (1.f / 192.f) + EPSF);
                if (li < 24) {
#pragma unroll
                    for (int j = 0; j < 8; ++j) w[j] = w[j] * rs * gkn[j]; }
                rope_apply<8>(w, 2, tc, ts, (cidx & 2) != 0, lat && ropelane);
                if (li < 24) st8bf(KM + (size_t)kvr * 1536 + head * 192 + 8 * li, w);
            }
        }
    }
}

DI void postC_phase(const Args& a, int tid, int G) {
    unsigned char* ws = a.ws;
    const bf16* RAWC = (const bf16*)(ws + WS_RAWC);
    bf16 *QC = (bf16*)(ws + WS_QC), *KC = (bf16*)(ws + WS_KC), *VC = (bf16*)(ws + WS_VC);
    const float* TB = (const float*)(ws + WS_TAB);
    const int lane = tid & 63, wave = tid >> 6, sub = lane & 7;
    float gqc[16], gkc[16];
    ld16f(a.in[33] + 16 * sub, gqc); ld16f(a.in[34] + 16 * sub, gkc);
    for (int r = blockIdx.x * NWAVES + wave; r < NTOK + 2048; r += G * NWAVES) {
        if (r < NTOK) {
            const bool isS = r >= NPT; const int t = (r - NPT) & 1023; const int prow = t >> 6, pcol = t & 63;
            const int kvr = kvrow_of(r);
            const bf16* raw = RAWC + (size_t)r * 3072;
            const int pos = (sub < 4) ? prow : pcol;
            float tc[16], ts[16];
            if (isS) { ld16f(TB + TB_C32 + pos * 32 + 16 * (sub & 1), tc); ld16f(TB + TB_S32 + pos * 32 + 16 * (sub & 1), ts); }
            else {
#pragma unroll
                for (int j = 0; j < 16; ++j) { tc[j] = 1.f; ts[j] = 0.f; } }
            float v[16];
            u32x4 rr[3][2];
#pragma unroll
            for (int p = 0; p < 2; ++p) { rr[p][0] = *(const u32x4*)(raw + p * 1024 + 16 * lane); rr[p][1] = *(const u32x4*)(raw + p * 1024 + 16 * lane + 8); }
            rr[2][0] = (u32x4){0u, 0u, 0u, 0u}; rr[2][1] = rr[2][0];
            if (lane < 32) { rr[2][0] = *(const u32x4*)(raw + 2048 + 16 * lane); rr[2][1] = *(const u32x4*)(raw + 2048 + 16 * lane + 8); }
#pragma unroll
            for (int p = 0; p < 2; ++p) {
                cv16(rr[p][0], rr[p][1], v);
                float ss = 0.f;
#pragma unroll
                for (int j = 0; j < 16; ++j) ss += v[j] * v[j];
                ss += __shfl_xor(ss, 1); ss += __shfl_xor(ss, 2); ss += __shfl_xor(ss, 4);
                const float rs = rsqrtf(ss * (1.f / 128.f) + EPSF);
#pragma unroll
                for (int j = 0; j < 16; ++j) v[j] = v[j] * rs * gqc[j];
                rope_apply<16>(v, 2, tc, ts, (sub & 2) != 0, isS);
                st16bf(QC + (size_t)r * 2048 + p * 1024 + 16 * lane, v);
            }
            cv16(rr[2][0], rr[2][1], v);
            const bool isk = lane < 32;
            { float ss = 0.f;
#pragma unroll
              for (int j = 0; j < 16; ++j) ss += v[j] * v[j];
              ss += __shfl_xor(ss, 1); ss += __shfl_xor(ss, 2); ss += __shfl_xor(ss, 4);
              const float rs = rsqrtf(ss * (1.f / 128.f) + EPSF);
              if (isk) {
#pragma unroll
                  for (int j = 0; j < 16; ++j) v[j] = v[j] * rs * gkc[j]; } }
            if (!isS && isk) st16f(a.out + OUT_GQK + (size_t)r * 512 + 16 * (lane & 31), v);
            rope_apply<16>(v, 2, tc, ts, (sub & 2) != 0, isS && isk);
            if (isk) st16bf(KC + (size_t)kvr * 512 + 16 * (lane & 31), v);
        } else {
            const int c = r - NTOK, b = c >> 9, p = c & 511; const int kvr = NPT + b * 1536 + p;
            float w[8];
            ld8f(a.in[6] + (size_t)c * 512 + 8 * lane, w); st8bf(KC + (size_t)kvr * 512 + 8 * lane, w);
            ld8f(a.in[7] + (size_t)c * 512 + 8 * lane, w); st8bf(VC + (size_t)kvr * 512 + 8 * lane, w);
        }
    }
}
constexpr int VT_LD = 72;
DI int crow(int i, int hi) { return (i & 3) + 8 * (i >> 2) + 4 * hi; }
DI float xmax32(float v) { const auto rr = __builtin_amdgcn_permlane32_swap(__builtin_bit_cast(unsigned, v), __builtin_bit_cast(unsigned, v), false, false); return fmaxf(__builtin_bit_cast(float, rr[0]), __builtin_bit_cast(float, rr[1])); }
DI float xsum32(float v) { const auto rr = __builtin_amdgcn_permlane32_swap(__builtin_bit_cast(unsigned, v), __builtin_bit_cast(unsigned, v), false, false); return __builtin_bit_cast(float, rr[0]) + __builtin_bit_cast(float, rr[1]); }

constexpr int KB_STRIDE = 25600, VT_BASE = 51200, VT_STRIDE = 20480, V_ROWB = 320;
typedef short v4i16_t __attribute__((ext_vector_type(4)));
DI s16x4 vtr(const LAS unsigned char* p) { return __builtin_bit_cast(s16x4, __builtin_amdgcn_ds_read_tr16_b64_v4i16((LAS v4i16_t*)p)); }
template <int DK, bool WINDOW>
DI void attn_core(f32x16 (&o)[4], const bf16* __restrict__ qp, const bf16* __restrict__ kbase, int kstride, const bf16* __restrict__ vbase, int vstride,
                  int nct, int lat_off, int nlt, float sl2, bool has_sink, float sinkl2, int q0, LAS unsigned char* lds, int tid) {
    constexpr int KS = DK + 8, NKS = DK / 16, NKC = DK / 64, CPR = DK / 8;
    const int lane = tid & 63, l32 = lane & 31, hi = lane >> 5;
    bf16x8 qf[NKS];
#pragma unroll
    for (int ks = 0; ks < NKS; ++ks) qf[ks] = *(const bf16x8*)(qp + ks * 16 + 8 * hi);
#pragma unroll
    for (int db = 0; db < 4; ++db)
#pragma unroll
        for (int i = 0; i < 16; ++i) o[db][i] = 0.f;
    const int vtr_off = (4 * hi + ((lane & 15) >> 2)) * V_ROWB + (16 * ((lane >> 4) & 1) + 4 * (lane & 3)) * 2;
    float m = -1e30f, l = 0.f;
    const float thr = 8.f / sl2;
    u32x4 kreg[NKC], vreg[2];
    const int ntiles = nct + nlt;
#define ATT_LOAD(T) do { const int _ko = (T) < nct ? (T) * 64 : lat_off + ((T) - nct) * 64; \
        _Pragma("unroll") for (int i = 0; i < NKC; ++i) { const int c = tid + 512 * i, key = c / CPR, part = c % CPR; kreg[i] = *(const u32x4*)(kbase + (size_t)(_ko + key) * kstride + part * 8); } \
        _Pragma("unroll") for (int i = 0; i < 2; ++i) { const int c = tid + 512 * i, key = c >> 4, part = c & 15; vreg[i] = *(const u32x4*)(vbase + (size_t)(_ko + key) * vstride + part * 8); } } while (0)
#define ATT_WRITE(B) do { LAS unsigned char* _kb = lds + (B) * KB_STRIDE; \
        _Pragma("unroll") for (int i = 0; i < NKC; ++i) { const int c = tid + 512 * i, key = c / CPR, part = c % CPR; *(LAS u32x4*)(_kb + (key * KS + part * 8) * 2) = kreg[i]; } \
        _Pragma("unroll") for (int i = 0; i < 2; ++i) { const int c = tid + 512 * i, key = c >> 4, part = c & 15; *(LAS u32x4*)(lds + VT_BASE + (B) * VT_STRIDE + key * V_ROWB + part * 16) = vreg[i]; } } while (0)
    ATT_LOAD(0);
    ATT_WRITE(0);
    if (ntiles > 1) ATT_LOAD(1);
    __syncthreads();
    for (int it = 0; it < ntiles; ++it) {
        const int koff = it < nct ? it * 64 : lat_off + (it - nct) * 64;
        const int buf = it & 1;
        const LAS unsigned char* kbuf = lds + buf * KB_STRIDE; const LAS unsigned char* vbuf = lds + VT_BASE + buf * VT_STRIDE;
        bool skip = false, domask = false;
        int kj0 = 0;
        if (WINDOW && it >= nct) { kj0 = koff - 512; skip = (kj0 > q0 + 31 + 128) || (kj0 + 63 < q0 - 128); domask = !((kj0 >= q0 + 31 - 128) && (kj0 + 63 <= q0 + 128)); }
        if (!skip) {
            f32x16 s[2];
#pragma unroll
            for (int kb = 0; kb < 2; ++kb) {
#pragma unroll
                for (int i = 0; i < 16; ++i) s[kb][i] = 0.f;
#pragma unroll
                for (int ks = 0; ks < NKS; ++ks) { const bf16x8 ka = *(const LAS bf16x8*)(kbuf + ((kb * 32 + l32) * KS + ks * 16 + 8 * hi) * 2); s[kb] = MFMA32(ka, qf[ks], s[kb]); if (DK > 128 && (ks & 3) == 3) __builtin_amdgcn_sched_barrier(0); }
            }
            if (WINDOW) { if (domask) {
#pragma unroll
                for (int kb = 0; kb < 2; ++kb)
#pragma unroll
                    for (int i = 0; i < 16; ++i) { const int kj = kj0 + kb * 32 + crow(i, hi); const int d = (q0 + l32) - kj; if (d > 128 || d < -128) s[kb][i] = -1e30f; } } }
            float tmax = fmaxf(s[0][0], s[1][0]);
#pragma unroll
            for (int i = 1; i < 16; ++i) tmax = fmaxf(tmax, fmaxf(s[0][i], s[1][i]));
            tmax = fmaxf(tmax, __shfl_xor(tmax, 32));
            if (__any(tmax > m + thr)) {
                const float mnew = fmaxf(m, tmax); const float alpha = __builtin_amdgcn_exp2f((m - mnew) * sl2); m = mnew; l *= alpha;
#pragma unroll
                for (int db = 0; db < 4; ++db)
#pragma unroll
                    for (int i = 0; i < 16; ++i) o[db][i] *= alpha;
            }
            const float nmsc = -m * sl2;
            float psum = 0.f;
#pragma unroll
            for (int kb = 0; kb < 2; ++kb)
#pragma unroll
                for (int i = 0; i < 16; ++i) { const float p = __builtin_amdgcn_exp2f(fmaf(s[kb][i], sl2, nmsc)); s[kb][i] = p; psum += p; }
            l += psum;
            bf16x8 pf[2][2];
#pragma unroll
            for (int kb = 0; kb < 2; ++kb)
#pragma unroll
                for (int st = 0; st < 2; ++st) { u32x4 w; w.x = pk2(s[kb][8 * st], s[kb][8 * st + 1]); w.y = pk2(s[kb][8 * st + 2], s[kb][8 * st + 3]); w.z = pk2(s[kb][8 * st + 4], s[kb][8 * st + 5]); w.w = pk2(s[kb][8 * st + 6], s[kb][8 * st + 7]);
                    pf[kb][st] = __builtin_bit_cast(bf16x8, w); }
#pragma unroll
            for (int kb = 0; kb < 2; ++kb)
#pragma unroll
                for (int st = 0; st < 2; ++st)
#pragma unroll
                    for (int db = 0; db < 4; ++db) { const LAS unsigned char* vp = vbuf + vtr_off + (kb * 32 + 16 * st) * V_ROWB + db * 64;
                        const s16x4 v0 = vtr(vp), v1 = vtr(vp + 8 * V_ROWB);
                        const bf16x8 va = __builtin_shufflevector(v0, v1, 0, 1, 2, 3, 4, 5, 6, 7);
                        o[db] = MFMA32(va, pf[kb][st], o[db]); }
        }
        if (it + 1 < ntiles) { ATT_WRITE(buf ^ 1); if (it + 2 < ntiles) ATT_LOAD(it + 2); }
        __syncthreads();
    }
#undef ATT_LOAD
#undef ATT_WRITE
    l += __shfl_xor(l, 32);
    if (has_sink) l += __builtin_amdgcn_exp2f(sinkl2 - m * sl2);
    const float inv = 1.f / l;
#pragma unroll
    for (int db = 0; db < 4; ++db)
#pragma unroll
        for (int i = 0; i < 16; ++i) o[db][i] *= inv;
}

constexpr int VT_OFF_SB = 32768;
template <int DK, bool WINDOW>
DI void attn_core_sb(f32x16 (&o)[4], const bf16* __restrict__ qp, const bf16* __restrict__ kbase, int kstride, const bf16* __restrict__ vbase, int vstride,
                  int nct, int lat_off, int nlt, float sl2, bool has_sink, float sinkl2, int q0, LAS unsigned char* lds, int tid) {
    constexpr int KS = DK + 8, NKS = DK / 16, NKC = DK / 64, CPR = DK / 8;
    const int lane = tid & 63, l32 = lane & 31, hi = lane >> 5;
    bf16x8 qf[NKS];
#pragma unroll
    for (int ks = 0; ks < NKS; ++ks) qf[ks] = *(const bf16x8*)(qp + ks * 16 + 8 * hi);
#pragma unroll
    for (int db = 0; db < 4; ++db)
#pragma unroll
        for (int i = 0; i < 16; ++i) o[db][i] = 0.f;
    const int vtr_off = (4 * hi + ((lane & 15) >> 2)) * V_ROWB + (16 * ((lane >> 4) & 1) + 4 * (lane & 3)) * 2;
    float m = -1e30f, l = 0.f;
    const float thr = 8.f / sl2;
    u32x4 kreg[NKC], vreg[2];
    const int ntiles = nct + nlt;
    {   const int koff = 0 < nct ? 0 : lat_off;
#pragma unroll
        for (int i = 0; i < NKC; ++i) { const int c = tid + 512 * i, key = c / CPR, part = c % CPR; kreg[i] = *(const u32x4*)(kbase + (size_t)(koff + key) * kstride + part * 8); }
#pragma unroll
        for (int i = 0; i < 2; ++i) { const int c = tid + 512 * i, key = c >> 4, part = c & 15; vreg[i] = *(const u32x4*)(vbase + (size_t)(koff + key) * vstride + part * 8); }
    }
    for (int it = 0; it < ntiles; ++it) {
        const int koff = it < nct ? it * 64 : lat_off + (it - nct) * 64;
        __syncthreads();
#pragma unroll
        for (int i = 0; i < NKC; ++i) { const int c = tid + 512 * i, key = c / CPR, part = c % CPR; *(LAS u32x4*)(lds + (key * KS + part * 8) * 2) = kreg[i]; }
#pragma unroll
        for (int i = 0; i < 2; ++i) { const int c = tid + 512 * i, key = c >> 4, part = c & 15; *(LAS u32x4*)(lds + VT_OFF_SB + key * V_ROWB + part * 16) = vreg[i]; }
        __syncthreads();
        if (it + 1 < ntiles) { const int kn = (it + 1) < nct ? (it + 1) * 64 : lat_off + (it + 1 - nct) * 64;
#pragma unroll
            for (int i = 0; i < NKC; ++i) { const int c = tid + 512 * i, key = c / CPR, part = c % CPR; kreg[i] = *(const u32x4*)(kbase + (size_t)(kn + key) * kstride + part * 8); }
#pragma unroll
            for (int i = 0; i < 2; ++i) { const int c = tid + 512 * i, key = c >> 4, part = c & 15; vreg[i] = *(const u32x4*)(vbase + (size_t)(kn + key) * vstride + part * 8); }
        }
        bool skip = false, domask = false;
        int kj0 = 0;
        if (WINDOW && it >= nct) { kj0 = koff - 512; skip = (kj0 > q0 + 31 + 128) || (kj0 + 63 < q0 - 128); domask = !((kj0 >= q0 + 31 - 128) && (kj0 + 63 <= q0 + 128)); }
        if (!skip) {
            f32x16 s[2];
#pragma unroll
            for (int kb = 0; kb < 2; ++kb) {
#pragma unroll
                for (int i = 0; i < 16; ++i) s[kb][i] = 0.f;
#pragma unroll
                for (int ks = 0; ks < NKS; ++ks) { const bf16x8 ka = *(const LAS bf16x8*)(lds + ((kb * 32 + l32) * KS + ks * 16 + 8 * hi) * 2); s[kb] = MFMA32(ka, qf[ks], s[kb]); }
            }
            if (WINDOW) { if (domask) {
#pragma unroll
                for (int kb = 0; kb < 2; ++kb)
#pragma unroll
                    for (int i = 0; i < 16; ++i) { const int kj = kj0 + kb * 32 + crow(i, hi); const int d = (q0 + l32) - kj; if (d > 128 || d < -128) s[kb][i] = -1e30f; } } }
            float tmax = fmaxf(s[0][0], s[1][0]);
#pragma unroll
            for (int i = 1; i < 16; ++i) tmax = fmaxf(tmax, fmaxf(s[0][i], s[1][i]));
            tmax = fmaxf(tmax, __shfl_xor(tmax, 32));
            if (__any(tmax > m + thr)) {
                const float mnew = fmaxf(m, tmax); const float alpha = __builtin_amdgcn_exp2f((m - mnew) * sl2); m = mnew; l *= alpha;
#pragma unroll
                for (int db = 0; db < 4; ++db)
#pragma unroll
                    for (int i = 0; i < 16; ++i) o[db][i] *= alpha;
            }
            const float nmsc = -m * sl2;
            float psum = 0.f;
#pragma unroll
            for (int kb = 0; kb < 2; ++kb)
#pragma unroll
                for (int i = 0; i < 16; ++i) { const float p = __builtin_amdgcn_exp2f(fmaf(s[kb][i], sl2, nmsc)); s[kb][i] = p; psum += p; }
            l += psum;
            bf16x8 pf[2][2];
#pragma unroll
            for (int kb = 0; kb < 2; ++kb)
#pragma unroll
                for (int st = 0; st < 2; ++st) { u32x4 w; w.x = pk2(s[kb][8 * st], s[kb][8 * st + 1]); w.y = pk2(s[kb][8 * st + 2], s[kb][8 * st + 3]); w.z = pk2(s[kb][8 * st + 4], s[kb][8 * st + 5]); w.w = pk2(s[kb][8 * st + 6], s[kb][8 * st + 7]);
                    pf[kb][st] = __builtin_bit_cast(bf16x8, w); }
#pragma unroll
            for (int db = 0; db < 4; ++db)
#pragma unroll
                for (int kb = 0; kb < 2; ++kb)
#pragma unroll
                    for (int st = 0; st < 2; ++st) { const LAS unsigned char* vp = lds + VT_OFF_SB + vtr_off + (kb * 32 + 16 * st) * V_ROWB + db * 64;
                        const s16x4 v0 = vtr(vp), v1 = vtr(vp + 8 * V_ROWB);
                        const bf16x8 va = __builtin_shufflevector(v0, v1, 0, 1, 2, 3, 4, 5, 6, 7);
                        o[db] = MFMA32(va, pf[kb][st], o[db]); }
        }
    }
    l += __shfl_xor(l, 32);
    if (has_sink) l += __builtin_amdgcn_exp2f(sinkl2 - m * sl2);
    const float inv = 1.f / l;
#pragma unroll
    for (int db = 0; db < 4; ++db)
#pragma unroll
        for (int i = 0; i < 16; ++i) o[db][i] *= inv;
}

DI void attn_store(const f32x16 (&o)[4], bf16* orow  , int hi) {
#pragma unroll
    for (int db = 0; db < 4; ++db)
#pragma unroll
        for (int g = 0; g < 4; ++g) { u32x2 w; w.x = pk2(o[db][4 * g], o[db][4 * g + 1]); w.y = pk2(o[db][4 * g + 2], o[db][4 * g + 3]);
            *(u32x2*)(orow + db * 32 + 8 * g + 4 * hi) = w; }
}

DI void attn0_unit(int u, int& b, int& h, int& r0, int& kv0, int& nct) {
    if (u < 128) { const int bh = (u & 7) + 8 * (u >> 5), qb = (u >> 3) & 3; b = bh >> 3; h = bh & 7;
        r0 = NPT + b * 1024 + qb * 256; kv0 = NPT + b * 1536; nct = 24; }
    else { const int v = u - 128; b = v >> 3; h = v & 7; r0 = b * 256; kv0 = b * 256; nct = 4; }
}
DI void attn0_da_phase(const Args& a, LAS unsigned char* lds, int tid, int G) {
    unsigned char* ws = a.ws;
    const bf16 *QDA = (const bf16*)(ws + WS_QDA), *KDA = (const bf16*)(ws + WS_KDA), *VDA = (const bf16*)(ws + WS_VDA);
    bf16* O = (bf16*)(ws + WS_H);
    const float lam = ((const float*)(ws + WS_TAB))[TB_LAM];
    const int lane = tid & 63, wave = tid >> 6, l32 = lane & 31, hi = lane >> 5;
    const bool deal = (G == 256); const int c0 = (int)blockIdx.x;
    const int ufirst = !deal ? c0 : (c0 < 128 ? c0 : 128 + 2 * (c0 - 128)), ucount = !deal ? 384 : (c0 < 128 ? 1 : 2), ustep = deal ? 1 : G;
    for (int ui = 0, u = ufirst; (deal ? ui < ucount : u < 384); ++ui, u += ustep) {
        int b, h, r0, kv0, nct; attn0_unit(u, b, h, r0, kv0, nct);
        const int qrow = r0 + 32 * wave + l32;
        f32x16 o[4];
        f32x4* stash = (f32x4*)((float*)(ws + WS_XA) + ((size_t)blockIdx.x * NTHR + tid) * 64);
        attn_core<64, false>(o, QDA + (size_t)qrow * 1024 + h * 128, KDA + (size_t)kv0 * 1024 + h * 128, 1024, VDA + (size_t)kv0 * 1024 + h * 128, 1024,
                             nct, 0, 0, 0.125f * LOG2E, false, 0.f, 0, lds, tid);
#pragma unroll
        for (int db = 0; db < 4; ++db)
#pragma unroll
            for (int i = 0; i < 4; ++i) stash[db * 4 + i] = (f32x4){o[db][4 * i], o[db][4 * i + 1], o[db][4 * i + 2], o[db][4 * i + 3]};
        attn_core<64, false>(o, QDA + (size_t)qrow * 1024 + h * 128 + 64, KDA + (size_t)kv0 * 1024 + h * 128 + 64, 1024, VDA + (size_t)kv0 * 1024 + h * 128, 1024,
                             nct, 0, 0, 0.125f * LOG2E, false, 0.f, 0, lds, tid);
        float ss = 0.f;
#pragma unroll
        for (int db = 0; db < 4; ++db)
#pragma unroll
            for (int i = 0; i < 4; ++i) { const f32x4 sv = stash[db * 4 + i];
#pragma unroll
                for (int e = 0; e < 4; ++e) { const float c = sv[e] - lam * o[db][4 * i + e]; o[db][4 * i + e] = c; ss += c * c; } }
        ss += __shfl_xor(ss, 32);
        const float rs = rsqrtf(ss * (1.f / 128.f) + EPSF) * 0.8f;
#pragma unroll
        for (int db = 0; db < 4; ++db)
#pragma unroll
            for (int i = 0; i < 16; ++i) o[db][i] = o[db][i] * rs * a.in[24][db * 32 + crow(i, hi)];
        attn_store(o, O + (size_t)qrow * 2048 + h * 128, hi);
    }
}
DI void attn0_mla_phase(const Args& a, LAS unsigned char* lds, int tid, int G) {
    unsigned char* ws = a.ws;
    const bf16 *QM = (const bf16*)(ws + WS_QMLA), *KM = (const bf16*)(ws + WS_KMLA), *VM = (const bf16*)(ws + WS_VMLA);
    bf16* O = (bf16*)(ws + WS_H);
    const int lane = tid & 63, wave = tid >> 6, l32 = lane & 31, hi = lane >> 5;
    for (int u = G - 1 - (int)blockIdx.x; u < 384; u += G) {
        int b, h, r0, kv0, nct; attn0_unit(u, b, h, r0, kv0, nct);
        const int qrow = r0 + 32 * wave + l32;
        f32x16 o[4];
        attn_core_sb<192, false>(o, QM + (size_t)qrow * 1536 + h * 192, KM + (size_t)kv0 * 1536 + h * 192, 1536, VM + (size_t)kv0 * 1024 + h * 128, 1024,
                              nct, 0, 0, 0.07216878364870322f * LOG2E, false, 0.f, 0, lds, tid);
        attn_store(o, O + (size_t)qrow * 2048 + 1024 + h * 128, hi);
    }
}

DI void attn1_phase(const Args& a, LAS unsigned char* lds, int tid, int G) {
    unsigned char* ws = a.ws;
    const bf16 *QC = (const bf16*)(ws + WS_QC), *KC = (const bf16*)(ws + WS_KC), *VC = (const bf16*)(ws + WS_VC);
    bf16* O = (bf16*)(ws + WS_H);
    const int lane = tid & 63, wave = tid >> 6, l32 = lane & 31, hi = lane >> 5;
    const float sl2 = 0.08838834764831845f * LOG2E;
    for (int u = blockIdx.x; u < 256; u += G) {
        f32x16 o[4];
        const int xw = (u >> 3) & 15, gk = (u & 7) + 8 * (u >> 7);
        const int b = gk >> 2, h = 4 * (gk & 3) + (xw >> 2), qb = xw & 3; const int r0 = NPT + b * 1024 + qb * 256, kv0 = NPT + b * 1536;
        const int lo = (256 * qb - 128) < 0 ? 0 : (256 * qb - 128), hi_k = (256 * qb + 384) > 1024 ? 1024 : (256 * qb + 384);
        const int qrow = r0 + 32 * wave + l32; const int kvh = h >> 2;
        attn_core<128, true>(o, QC + (size_t)qrow * 2048 + h * 128, KC + (size_t)kv0 * 512 + kvh * 128, 512, VC + (size_t)kv0 * 512 + kvh * 128, 512,
                             8, 512 + lo, (hi_k - lo) >> 6, sl2, true, a.in[35][h] * LOG2E, 256 * qb + 32 * wave, lds, tid);
        attn_store(o, O + (size_t)qrow * 2048 + h * 128, hi);
    }
    for (int v = blockIdx.x; v < 512; v += G) {
        f32x16 o[4];
        const int cc = v & 255, grp = (cc & 7) + 8 * (cc >> 5) + 64 * (v >> 8);
        const int b = grp >> 2, h = 4 * (grp & 3) + ((cc >> 3) & 3); const int r0 = b * 256, kv0 = b * 256;
        const int qrow = r0 + 32 * wave + l32; const int kvh = h >> 2;
        attn_core<128, false>(o, QC + (size_t)qrow * 2048 + h * 128, KC + (size_t)kv0 * 512 + kvh * 128, 512, VC + (size_t)kv0 * 512 + kvh * 128, 512,
                              4, 0, 0, sl2, true, a.in[35][h] * LOG2E, 0, lds, tid);
        attn_store(o, O + (size_t)qrow * 2048 + h * 128, hi);
    }
}
#define XB_TMO      128
#define XB_XCNT(j)  (256  + 64 * (j))
#define XB_XSUB(j)  (1280 + 64 * (j))
#define XB_XGEN(j)  (2304 + 64 * (j))
#define XB_TOP      3328
#define XB_TOPGEN   3392
#define XCD_BAR_WORDS 3456
#define XB_SPIN_CAP (1u << 18)

__device__ __forceinline__ unsigned xb_ld(unsigned* p)              { return __hip_atomic_load(p, __ATOMIC_RELAXED, __HIP_MEMORY_SCOPE_AGENT); }
__device__ __forceinline__ unsigned xb_add(unsigned* p, unsigned v) { return __hip_atomic_fetch_add(p, v, __ATOMIC_RELAXED, __HIP_MEMORY_SCOPE_AGENT); }
__device__ __forceinline__ unsigned xb_xcc_id() { return (unsigned)__builtin_amdgcn_s_getreg((3 << 11) | 20) & 0xFu; }
#define XB_SPIN(cond, bar) do { unsigned _sp = 0; while (cond) { __builtin_amdgcn_s_sleep(1); \
    if ((++_sp & 255u) == 0u) { if (xb_ld(&(bar)[XB_TMO])) break; if (_sp > XB_SPIN_CAP) { atomicAdd(&(bar)[XB_TMO], 1u); break; } } } } while (0)

struct XcdBarrier {
    unsigned* bar; unsigned x;
    volatile LAS unsigned* st;
};

__device__ __forceinline__ XcdBarrier xcd_barrier_post(unsigned* bar, volatile LAS unsigned* st) {
    XcdBarrier b; b.bar = bar; b.x = xb_xcc_id(); b.st = st;
    if (threadIdx.x == 0) (void)xb_add(&bar[XB_XCNT(b.x)], 1u);
    return b;
}
__device__ __forceinline__ void xcd_barrier_complete(unsigned* bar, unsigned x, unsigned& nloc, unsigned& nx) {
    const unsigned G = gridDim.x * gridDim.y * gridDim.z;
    unsigned sum, cnt, mine, sp = 0u;
    for (;;) {
        sum = 0u; cnt = 0u; mine = 0u;
#pragma unroll
        for (unsigned j = 0; j < 16; ++j) { const unsigned c = xb_ld(&bar[XB_XCNT(j)]); sum += c; cnt += (c > 0u) ? 1u : 0u; mine = (j == x) ? c : mine; }
        if (sum == G) break;
        __builtin_amdgcn_s_sleep(1);
        if ((++sp & 255u) == 0u) { if (xb_ld(&bar[XB_TMO])) break; if (sp > XB_SPIN_CAP) { atomicAdd(&bar[XB_TMO], 1u); break; } }
    }
    nloc = mine > 0u ? mine : 1u; nx = cnt > 0u ? cnt : 1u;
}

__device__ __forceinline__ void xcd_barrier(const XcdBarrier& b) {
    asm volatile("s_waitcnt vmcnt(0)" ::: "memory");
    __syncthreads();
    if (threadIdx.x == 0) {
        unsigned* bar = b.bar;
        __builtin_amdgcn_s_waitcnt(0);
        unsigned nloc = b.st[0], nx = b.st[1];
        if (nloc == 0u) { xcd_barrier_complete(bar, b.x, nloc, nx); b.st[0] = nloc; b.st[1] = nx; }
        const unsigned old = xb_add(&bar[XB_XSUB(b.x)], 1u);
        const unsigned gen = old / nloc;
        if (old + 1u == (gen + 1u) * nloc) {
            __builtin_amdgcn_fence(__ATOMIC_RELEASE, "agent");
            asm volatile("s_waitcnt vmcnt(0)" ::: "memory");
            const unsigned og = xb_add(&bar[XB_TOP], 1u);
            const unsigned tg = og / nx;
            if (og + 1u == (tg + 1u) * nx) xb_add(&bar[XB_TOPGEN], 1u);
            else XB_SPIN(xb_ld(&bar[XB_TOPGEN]) == tg, bar);
            __builtin_amdgcn_fence(__ATOMIC_ACQUIRE, "agent");
            xb_add(&bar[XB_XGEN(b.x)], 1u);
            asm volatile("s_waitcnt vmcnt(0)" ::: "memory");
        } else {
            XB_SPIN(xb_ld(&bar[XB_XGEN(b.x)]) == gen, bar);
            __builtin_amdgcn_fence(__ATOMIC_ACQUIRE, "agent");
            asm volatile("s_waitcnt vmcnt(0)" ::: "memory");
        }
    }
    __syncthreads();
}

#ifndef DUP_DA
#define DUP_DA 1
#endif
#ifndef DUP_MLA
#define DUP_MLA 1
#endif
#ifndef MK_COOP
#define MK_COOP 1
#endif
constexpr int NPH = 20;
__global__ void __launch_bounds__(NTHR, 2) mega_fwd(Args a) {
    extern __shared__ __attribute__((aligned(16))) unsigned char lds_raw[];
    LAS unsigned char* lds = (LAS unsigned char*)lds_raw;
    const int tid = threadIdx.x, G = gridDim.x;
    const int lo = a.ph_lo, hi = a.ph_hi;
    volatile LAS unsigned* st = (volatile LAS unsigned*)(lds + LDS_BYTES - 16);
    if (tid < 4) st[tid] = 0u;
    __syncthreads();
    XcdBarrier bar; bar.bar = nullptr; bar.x = 0; bar.st = st;
#ifndef PHMASK
#define PHMASK 0xFFFFF
#endif
#ifndef DUPMASK
#define DUPMASK 0
#endif
#define REPS(k) (1 + ((DUPMASK >> (k)) & 1))
#define IN(k) (((PHMASK >> (k)) & 1) && lo <= (k) && (k) < hi)
#define SYNC(k) do { if (lo <= (k) && (k) + 1 < hi && a.coop) { if ((k) == 0) { cg::this_grid().sync(); bar = xcd_barrier_post(WSP(unsigned, WS_BAR), st); } else xcd_barrier(bar); } } while (0)
#define WSP(T, off) ((T*)(a.ws + (off)))
#define MODP ((const float*)(a.ws + WS_MOD))
#define XS_OFF (a.in[1] - (size_t)NPT * DM)
#define GEMM_BF16M(ACT, MODE, Aptr, Bptr, M_, N_, K_, Optr, cid, V2_, F2_) do { pg8::Gemm g{Aptr, Bptr, M_, N_, K_}; pg8::StaticOrder S; S.init(M_, N_, K_, G, cid); pg8::EpiBf16<ACT, MODE> E{Optr, N_, V2_, F2_}; \
        pg8::gemm_phase<pg8::EpiBf16<ACT, MODE>, pg8::StaticOrder, true, true>(lds, g, S, E); } while (0)
#define GEMM_BF16(ACT, Aptr, Bptr, M_, N_, K_, Optr, cid) GEMM_BF16M(ACT, 0, Aptr, Bptr, M_, N_, K_, Optr, cid, nullptr, nullptr)
#define GEMM_RES(Aptr, Bptr, K_, xp_, xs_, out_, gate_, fl_) do { pg8::Gemm g{Aptr, Bptr, NTOK, 2048, K_}; pg8::HalfShareOrder S; S.init(NTOK, 2048, K_, G, (int)blockIdx.x, (fl_) >= 0); pg8::EpiResid E{xp_, xs_, out_, gate_, WSP(f32x4, WS_PART), WSP(unsigned, WS_FLAGS) + 128 * ((fl_) < 0 ? 0 : (fl_))}; \
        pg8::gemm_phase<pg8::EpiResid, pg8::HalfShareOrder, true, true>(lds, g, S, E); } while (0)
    if (IN(0)) for (int rep = 0; rep < REPS(0); ++rep) phase0(a, lds, tid, G);
    SYNC(0);
    if (IN(1)) for (int rep = 0; rep < REPS(1); ++rep) norm_phase(a.in[0], XS_OFF, a.in[10], MODP, 0, 2048, WSP(bf16, WS_H), tid, G);
    SYNC(1);
    if (IN(2)) for (int rep = 0; rep < REPS(2); ++rep) { GEMM_BF16M(0, 2, WSP(const bf16, WS_H), WSP(const bf16, WS_WIN0), NTOK, ABP, 2048, WSP(bf16, WS_RAW), (int)blockIdx.x, WSP(bf16, WS_VDA), a.out + OUT_DAV); bg_convert(a, lds, tid, G, (NTOK / 256) * (ABP / 256), CI_A, CI_B); }
    SYNC(2);
    if (IN(3)) for (int rep = 0; rep < REPS(3); ++rep) postA_phase(a, tid, G);
    SYNC(3);
    if (IN(4)) for (int rep = 0; rep < REPS(4); ++rep) GEMM_BF16(0, WSP(const bf16, WS_MQN), WSP(const bf16, WS_WQUP), NTOK, 1536, 512, WSP(bf16, WS_RAW2), (int)blockIdx.x);
    if (IN(5)) for (int rep = 0; rep < REPS(5); ++rep) GEMM_BF16M(0, 1, WSP(const bf16, WS_CKV), WSP(const bf16, WS_WKVUP), NKV, 2048, 512, WSP(bf16, WS_RAW3), G - 1 - (int)blockIdx.x, WSP(bf16, WS_VMLA), nullptr);
    SYNC(5);
    if (IN(6)) for (int rep = 0; rep < REPS(6); ++rep) postB_phase(a, tid, G);
    SYNC(6);
    if (IN(7)) for (int rep = 0; rep < REPS(7); ++rep) {
#ifndef NO_DA
        _Pragma("unroll 1") for (int r2 = 0; r2 < (DUP_DA == 2 ? 1 + a.coop : 1); ++r2) attn0_da_phase(a, lds, tid, G);
#endif
#ifndef NO_MLA
        _Pragma("unroll 1") for (int r2 = 0; r2 < (DUP_MLA == 2 ? 1 + a.coop : 1); ++r2) attn0_mla_phase(a, lds, tid, G);
#endif
    }
    SYNC(7);
    if (IN(8)) for (int rep = 0; rep < REPS(8); ++rep) { GEMM_RES(WSP(const bf16, WS_H), WSP(const bf16, WS_WOUT0), 2048, a.in[0], XS_OFF, WSP(float, WS_XA), MODP + 2 * 2048, -1); bg_convert(a, lds, tid, G, (NTOK / 256) * 8, CI_B, CI_C); }
    SYNC(8);
    if (IN(9)) for (int rep = 0; rep < REPS(9); ++rep) norm_phase(WSP(const float, WS_XA), WSP(const float, WS_XA), a.in[11], MODP, 3 * 2048, 4 * 2048, WSP(bf16, WS_H), tid, G);
    SYNC(9);
    if (IN(10)) for (int rep = 0; rep < REPS(10); ++rep) GEMM_BF16(1, WSP(const bf16, WS_H), WSP(const bf16, WS_WFF1), NTOK, FFD, 2048, WSP(bf16, WS_FFH), (int)blockIdx.x);
    SYNC(10);
    if (IN(11)) for (int rep = 0; rep < REPS(11); ++rep) { GEMM_RES(WSP(const bf16, WS_FFH), WSP(const bf16, WS_WFF2), FFD, WSP(const float, WS_XA), WSP(const float, WS_XA), WSP(float, WS_XB), MODP + 5 * 2048, 1); }
    SYNC(11);
    if (IN(12)) for (int rep = 0; rep < REPS(12); ++rep) norm_phase(WSP(const float, WS_XB), WSP(const float, WS_XB), a.in[10] + 2048, MODP + 5 * 12288, 0, 2048, WSP(bf16, WS_H), tid, G);
    SYNC(12);
    if (IN(13)) for (int rep = 0; rep < REPS(13); ++rep) { GEMM_BF16M(0, 3, WSP(const bf16, WS_H), WSP(const bf16, WS_WCIN), NTOK, 3072, 2048, WSP(bf16, WS_RAWC), (int)blockIdx.x, WSP(bf16, WS_VC), a.out + OUT_GQV); bg_convert(a, lds, tid, G, (NTOK / 256) * 12, CI_C, CI_END); }
    SYNC(13);
    if (IN(14)) for (int rep = 0; rep < REPS(14); ++rep) postC_phase(a, tid, G);
    SYNC(14);
    if (IN(15)) for (int rep = 0; rep < REPS(15); ++rep) attn1_phase(a, lds, tid, G);
    SYNC(15);
    if (IN(16)) for (int rep = 0; rep < REPS(16); ++rep) GEMM_RES(WSP(const bf16, WS_H), WSP(const bf16, WS_WCOUT), 2048, WSP(const float, WS_XB), WSP(const float, WS_XB), WSP(float, WS_XA), MODP + 5 * 12288 + 2 * 2048, 2);
    SYNC(16);
    if (IN(17)) for (int rep = 0; rep < REPS(17); ++rep) norm_phase(WSP(const float, WS_XA), WSP(const float, WS_XA), a.in[11] + 2048, MODP + 5 * 12288, 3 * 2048, 4 * 2048, WSP(bf16, WS_H), tid, G);
    SYNC(17);
    if (IN(18)) for (int rep = 0; rep < REPS(18); ++rep) GEMM_BF16(1, WSP(const bf16, WS_H), WSP(const bf16, WS_WFF1) + (size_t)FFD * 2048, NTOK, FFD, 2048, WSP(bf16, WS_FFH), (int)blockIdx.x);
    SYNC(18);
    if (IN(19)) for (int rep = 0; rep < REPS(19); ++rep) GEMM_RES(WSP(const bf16, WS_FFH), WSP(const bf16, WS_WFF2) + (size_t)FFD * 2048, FFD, WSP(const float, WS_XA), WSP(const float, WS_XA), a.out + OUT_Y, MODP + 5 * 12288 + 5 * 2048, 3);
}

extern "C" void kernel_launch(void* const* d_in, const int* in_sizes, int n_in, void* d_out, int out_size, void* d_ws, size_t ws_size, hipStream_t stream) {
    static int grid = 0;
    if (grid == 0) {
        if (n_in != 36 || ws_size < WS_END) { fprintf(stderr, "kernel_launch: unexpected n_in %d / ws %zu (need %zu)\n", n_in, ws_size, (size_t)WS_END); grid = -1; return; }
        int dev = 0, cus = 0, per_cu = 0;
        hipGetDevice(&dev); hipDeviceGetAttribute(&cus, hipDeviceAttributeMultiprocessorCount, dev);
        if (hipFuncSetAttribute((const void*)mega_fwd, hipFuncAttributeMaxDynamicSharedMemorySize, LDS_BYTES) != hipSuccess) { fprintf(stderr, "kernel_launch: hipFuncSetAttribute failed\n"); grid = -1; return; }
        if (hipOccupancyMaxActiveBlocksPerMultiprocessor(&per_cu, (const void*)mega_fwd, NTHR, LDS_BYTES) != hipSuccess || per_cu < 1) { fprintf(stderr, "kernel_launch: occupancy query says %d\n", per_cu); per_cu = 1; }
        (void)hipGetLastError();
        grid = cus * per_cu;
        fprintf(stderr, "kernel_launch: grid %d (cus %d x %d)\n", grid, cus, per_cu);
    }
    if (grid < 0) return;
    Args a{};
    for (int i = 0; i < 36; ++i) a.in[i] = (const float*)d_in[i];
    a.out = (float*)d_out; a.ws = (unsigned char*)d_ws;
#if MK_COOP
    a.ph_lo = 0; a.ph_hi = NPH; a.coop = 1;
    void* args[] = {&a};
    hipError_t e = hipLaunchCooperativeKernel((const void*)mega_fwd, dim3(grid), dim3(NTHR), args, LDS_BYTES, stream);
    if (e != hipSuccess) fprintf(stderr, "cooperative launch failed: %s (grid %d)\n", hipGetErrorString(e), grid);
#else
#ifndef HOSTDUP
#define HOSTDUP 0
#endif
    for (int ph = 0; ph < NPH; ++ph) { a.ph_lo = ph; a.ph_hi = ph + 1; a.coop = 0;
        for (int rep = 0; rep < 1 + ((HOSTDUP >> ph) & 1); ++rep) hipLaunchKernelGGL(mega_fwd, dim3(grid), dim3(NTHR), LDS_BYTES, stream, a); }
#endif
}
```

```cpp
#include <hip/hip_runtime.h>
#include <hip/hip_cooperative_groups.h>
#include <cstdio>
#include <cstdint>
namespace cg = cooperative_groups;
namespace pg8 {
#define PG8_LAS __attribute__((address_space(3)))
typedef unsigned short bf16_t;
typedef short bf16x8 __attribute__((ext_vector_type(8)));
typedef float f32x4 __attribute__((ext_vector_type(4)));
typedef unsigned u32x4 __attribute__((ext_vector_type(4)));
constexpr int BM = 256, BK = 64, HALF = 128, HTB = HALF * BK * 2  , STAGE_BYTES = 8 * HTB, NXCD = 8, WGM = 8;

__host__ __device__ __forceinline__ int lds_byte(int r, int c) { const int st = (r >> 4) * 2 + (c >> 5), rr = r & 15, cc = c & 31, ob = rr * 64 + cc * 2; return st * 1024 + (ob ^ (((ob >> 9) & 1) << 5)); }
__host__ __device__ __forceinline__ void stage_rc(int b, int& R, int& C) { const int st = b / 1024, sb = b % 1024, swz = sb ^ (((sb >> 9) & 1) << 5); R = (st >> 1) * 16 + swz / 64; C = (st & 1) * 32 + (swz % 64) / 2; }
__host__ __device__ __forceinline__ int perm32(int rho) { const int n = rho >> 4, i = rho & 15; return 8 * (i >> 2) + 4 * n + (i & 3); }

struct Unit { int pm, pn, koff, nt, role, sj; };
struct Gemm { const bf16_t* A; const bf16_t* Bt; int M, N, K; };

struct StaticOrder {
    int nM, nN, nwg, G, c, ntk;
    __host__ __device__ void init(int M, int N, int K, int G_, int c_) { nM = M / BM; nN = N / BM; nwg = nM * nN; G = G_; c = c_; ntk = K / BK; }
    __host__ __device__ void decode(int wgid, Unit& u) const { { const int q = nwg / NXCD, r = nwg % NXCD, xcd = wgid % NXCD, off = wgid / NXCD; wgid = (xcd < r ? xcd * (q + 1) : r * (q + 1) + (xcd - r) * q) + off; }
        const int nig = WGM * nN, gid = wgid / nig, fm = gid * WGM, gsz = (nM - fm) < WGM ? (nM - fm) : WGM;
        u.pm = fm + ((wgid % nig) % gsz); u.pn = (wgid % nig) / gsz; u.koff = 0; u.nt = ntk; u.role = 0; u.sj = 0; }
    __host__ __device__ bool next(int i, Unit& u) const {
        const long L = (long)i * G + c; if (L >= nwg) return false;
        decode((int)L, u); return true;
    }
    __device__ __forceinline__ void a_ready(const Unit&) const {}
    __device__ __forceinline__ void done(const Unit&) const {}
};
struct HalfShareOrder {
    StaticOrder so; int c; bool share;
    __host__ __device__ void init(int M, int N, int K, int G_, int c_, bool share_) { so.init(M, N, K, G_, c_); c = c_; share = share_; }
    __host__ __device__ bool next(int i, Unit& u) const {
        if (!share || so.G != 256 || so.nwg != 384) return so.next(i, u);
        if (i >= 2) return false;
        const bool even = !(c & 8); const int j = ((c >> 4) << 3) | (c & 7);
        const bool whole = even ? (i == 0) : (i == 1);
        so.decode(whole ? c : 256 + j, u);
        if (!whole) { u.nt = so.ntk / 2; u.koff = even ? 0 : (so.ntk / 2) * BK; u.role = even ? 2 : 1; u.sj = j; }
        return true;
    }
    __device__ __forceinline__ void a_ready(const Unit&) const {}
    __device__ __forceinline__ void done(const Unit&) const {}
};
__device__ __forceinline__ unsigned cvt_pk_bf16(float lo, float hi) { unsigned r; asm volatile("v_cvt_pk_bf16_f32 %0, %1, %2" : "=v"(r) : "v"(lo), "v"(hi)); return r; }
typedef float f32x2 __attribute__((ext_vector_type(2)));
template <int ACT, int MODE = 0> struct EpiBf16 {
    static constexpr bool PERM = true, AFTER_DRAIN = false;
    bf16_t* O; int ldc; bf16_t* V2; float* F2;
    __device__ __forceinline__ void operator()(const f32x4 (&acc)[2][2][4][2], const Unit& u, int wr, int wc, int fr, int fq) const {
        const int row0 = u.pm * BM + wr * 64 + fr; const int col0 = u.pn * BM + wc * 32 + 8 * fq;
        const bool redirect = (MODE == 2) ? (u.pn >= 8 && u.pn < 12) : (MODE == 3) ? (u.pn >= 10) : false;
        const int koff = (u.pm < 32) ? 0 : (((u.pm - 32) >> 2) * 512 + 512);
        const int vp = (MODE == 2) ? 1024 : 512;
        const int vc0 = (MODE == 2) ? (u.pn - 8) * 256 + wc * 32 + 8 * fq : (u.pn - 10) * 256 + wc * 32 + 8 * fq;
#pragma unroll
        for (int ai = 0; ai < 2; ++ai)
#pragma unroll
            for (int m = 0; m < 4; ++m) { const int row = row0 + ai * HALF + m * 16; bf16_t* rowp = O + (size_t)row * ldc + col0;
#pragma unroll
                for (int bj = 0; bj < 2; ++bj) { f32x4 v0 = acc[ai][bj][m][0], v1 = acc[ai][bj][m][1];
                    if (ACT == 1) {
#pragma unroll
                        for (int e = 0; e < 4; ++e) { float a = v0[e] > 0.f ? v0[e] : 0.f; v0[e] = a * a; float b = v1[e] > 0.f ? v1[e] : 0.f; v1[e] = b * b; }
                    }
                    u32x4 w; w.x = cvt_pk_bf16(v0[0], v0[1]); w.y = cvt_pk_bf16(v0[2], v0[3]); w.z = cvt_pk_bf16(v1[0], v1[1]); w.w = cvt_pk_bf16(v1[2], v1[3]);
                    if (MODE == 1 && bj == 1) { *(u32x4*)(V2 + (size_t)row * 1024 + u.pn * 128 + wc * 32 + 8 * fq) = w; }
                    else if ((MODE == 2 || MODE == 3) && redirect) {
                        *(u32x4*)(V2 + (size_t)(row + koff) * vp + vc0 + bj * HALF) = w;
                        if (u.pm < 32) { float* fp = F2 + (size_t)row * vp + vc0 + bj * HALF; *(f32x4*)fp = v0; *(f32x4*)(fp + 4) = v1; }
                    }
                    else *(u32x4*)(rowp + bj * HALF) = w; } }
    }
};
struct EpiResid {
    static constexpr bool PERM = true, AFTER_DRAIN = false;
    const float* xin_p; const float* xin_s; float* out; const float* gate; f32x4* part; unsigned* flags;
    __device__ __forceinline__ void operator()(const f32x4 (&acc)[2][2][4][2], const Unit& u, int wr, int wc, int fr, int fq) const {
        const int tid = threadIdx.x;
        if (u.role == 1) {
            const __amdgpu_buffer_rsrc_t rs = __builtin_amdgcn_make_buffer_rsrc((void*)part, 0, 32 << 20, 0x00020000);
            const unsigned boff = (unsigned)(u.sj * 16384 + tid) * 16u;
#pragma unroll
            for (int ai = 0; ai < 2; ++ai)
#pragma unroll
                for (int bj = 0; bj < 2; ++bj)
#pragma unroll
                    for (int m = 0; m < 4; ++m)
#pragma unroll
                        for (int n = 0; n < 2; ++n) __builtin_amdgcn_raw_buffer_store_b128(__builtin_bit_cast(u32x4, acc[ai][bj][m][n]), rs, boff + (unsigned)((((ai * 2 + bj) * 4 + m) * 2 + n) * 512 * 16), 0, 16);
            asm volatile("s_waitcnt vmcnt(0)" ::: "memory");
            __syncthreads();
            if (tid == 0) __hip_atomic_store(flags + u.sj, 1u, __ATOMIC_RELAXED, __HIP_MEMORY_SCOPE_AGENT);
            return;
        }
        const bool red = u.role == 2;
        if (red) {
            if (tid == 0) { while (__hip_atomic_load(flags + u.sj, __ATOMIC_RELAXED, __HIP_MEMORY_SCOPE_AGENT) == 0u) __builtin_amdgcn_s_sleep(2);
                __builtin_amdgcn_fence(__ATOMIC_ACQUIRE, "agent"); }
            asm volatile("s_waitcnt vmcnt(0)" ::: "memory");
            __syncthreads();
        }
        const f32x4* p = part + (size_t)u.sj * 16384 + tid;
        const int row0 = u.pm * BM + wr * 64 + fr; const int col0 = u.pn * BM + wc * 32 + 8 * fq;
        const int cond = (u.pm < 32) ? 0 : 1 + ((u.pm - 32) >> 2);
        const float* xin = (u.pm < 32) ? xin_p : xin_s;
        const float* gp = gate + (size_t)cond * 12288 + col0;
        f32x4 gv[2][2];
#pragma unroll
        for (int bj = 0; bj < 2; ++bj)
#pragma unroll
            for (int n = 0; n < 2; ++n) gv[bj][n] = *(const f32x4*)(gp + bj * HALF + 4 * n);
#pragma unroll
        for (int ai = 0; ai < 2; ++ai)
#pragma unroll
            for (int m = 0; m < 4; ++m) { const size_t off = (size_t)(row0 + ai * HALF + m * 16) * 2048 + col0;
#pragma unroll
                for (int bj = 0; bj < 2; ++bj)
#pragma unroll
                    for (int n = 0; n < 2; ++n) { const f32x4 xv = *(const f32x4*)(xin + off + bj * HALF + 4 * n);
                        f32x4 av = acc[ai][bj][m][n];
                        if (red) av += p[(((ai * 2 + bj) * 4 + m) * 2 + n) * 512];
                        *(f32x4*)(out + off + bj * HALF + 4 * n) = xv + gv[bj][n] * av; } }
    }
};
template <class Epi, class Sched, bool ALIGN_EPI = false, bool SP2 = false>
__device__ __forceinline__ void gemm_phase(PG8_LAS unsigned char* lds, const Gemm g, const Sched& S, const Epi& E) {
    const int tid = threadIdx.x, wid = __builtin_amdgcn_readfirstlane(tid >> 6), lane = tid & 63, wr = wid >> 2, wc = wid & 3, fr = lane & 15, fq = lane >> 4;
    const int K = g.K;
    unsigned voffA[2], voffB[2];
#pragma unroll
    for (int i = 0; i < 2; ++i) { int R, C; stage_rc(tid * 16 + i * 8192, R, C); const int Rb = Epi::PERM ? ((R & ~31) + perm32(R & 31)) : R;
        voffA[i] = (unsigned)(R * K + C) * 2u; voffB[i] = (unsigned)(Rb * K + C) * 2u; }
    const size_t kstep = (size_t)(BK * 2);
    const size_t hstep = (size_t)HALF * K * 2;
    const size_t tstep = 2 * hstep;
    const unsigned ldsw = (unsigned)wid * 1024u;
    const int aoff = lds_byte(wr * 64 + fr, fq * 8), boff = lds_byte(wc * 32 + fr, fq * 8);
#define PG8_SA(b, h) (((b) * 2 + (h)) * HTB)
#define PG8_SB(b, h) ((4 + (b) * 2 + (h)) * HTB)
#define PG8_STAGE(bufoff, gbase, voff) do { _Pragma("unroll") for (int _i = 0; _i < 2; ++_i) \
        __builtin_amdgcn_global_load_lds((const unsigned*)((const char*)(gbase) + (voff)[_i]), (PG8_LAS unsigned*)(lds + (bufoff) + ldsw + _i * 8192), 16, 0, 0); } while (0)
#define PG8_LDA(dst, b, h) do { _Pragma("unroll") for (int m = 0; m < 4; ++m) _Pragma("unroll") for (int k = 0; k < 2; ++k) dst[m][k] = *(const PG8_LAS bf16x8*)(lds + PG8_SA(b, h) + aoff + m * 2048 + k * 1024); } while (0)
#define PG8_LDB(dst, b, h) do { _Pragma("unroll") for (int n = 0; n < 2; ++n) _Pragma("unroll") for (int k = 0; k < 2; ++k) dst[n][k] = *(const PG8_LAS bf16x8*)(lds + PG8_SB(b, h) + boff + n * 2048 + k * 1024); } while (0)
#define PG8_MMA(ai, bj, At, Bt) do { __builtin_amdgcn_s_setprio(1); _Pragma("unroll") for (int m = 0; m < 4; ++m) _Pragma("unroll") for (int n = 0; n < 2; ++n) _Pragma("unroll") for (int k = 0; k < 2; ++k) \
        acc[ai][bj][m][n] = __builtin_amdgcn_mfma_f32_16x16x32_bf16(Bt[n][k], At[m][k], acc[ai][bj][m][n], 0, 0, 0); __builtin_amdgcn_s_setprio(0); } while (0)
#define PG8_WAIT_V(n) asm volatile("s_waitcnt vmcnt(" #n ")" ::: "memory")
#define PG8_WAIT_L(n) asm volatile("s_waitcnt lgkmcnt(" #n ")" ::: "memory")
#define PG8_BAR __builtin_amdgcn_s_barrier()
#define PG8_SCHED __builtin_amdgcn_sched_barrier(0)
    Unit cur, nxt; int ui = 0;
    if (!S.next(0, cur)) return;
    f32x4 acc[2][2][4][2];
#pragma unroll
    for (int a = 0; a < 2; ++a)
#pragma unroll
        for (int b = 0; b < 2; ++b)
#pragma unroll
            for (int m = 0; m < 4; ++m)
#pragma unroll
                for (int n = 0; n < 2; ++n) acc[a][b][m][n] = (f32x4){0.f, 0.f, 0.f, 0.f};
    bf16x8 At[4][2], B0[2][2], B1[2][2];
    const char* cA = (const char*)g.A + (size_t)cur.pm * tstep + (size_t)cur.koff * 2; const char* cB = (const char*)g.Bt + (size_t)cur.pn * tstep + (size_t)cur.koff * 2;
    S.a_ready(cur);
    if constexpr (SP2) {
        PG8_STAGE(PG8_SB(0, 0), cB, voffB); PG8_STAGE(PG8_SB(0, 1), cB + hstep, voffB); PG8_STAGE(PG8_SA(0, 0), cA, voffA); PG8_STAGE(PG8_SA(0, 1), cA + hstep, voffA);
        if (wr == 1) PG8_BAR;
        PG8_WAIT_V(2); PG8_BAR;
        PG8_STAGE(PG8_SB(1, 0), cB + kstep, voffB); PG8_STAGE(PG8_SA(1, 0), cA + kstep, voffA); PG8_STAGE(PG8_SB(1, 1), cB + hstep + kstep, voffB);
        PG8_WAIT_V(6); PG8_BAR;
    } else {
        PG8_STAGE(PG8_SB(0, 0), cB, voffB); PG8_STAGE(PG8_SA(0, 0), cA, voffA); PG8_STAGE(PG8_SB(0, 1), cB + hstep, voffB); PG8_STAGE(PG8_SA(0, 1), cA + hstep, voffA);
        if (wr == 1) PG8_BAR;
        PG8_WAIT_V(4); PG8_BAR;
        PG8_STAGE(PG8_SB(1, 0), cB + kstep, voffB); PG8_STAGE(PG8_SA(1, 0), cA + kstep, voffA); PG8_STAGE(PG8_SB(1, 1), cB + hstep + kstep, voffB);
        PG8_WAIT_V(6); PG8_BAR;
    }
    for (;;) {
        const bool has_next = S.next(ui + 1, nxt);
        const char* nA = has_next ? (const char*)g.A + (size_t)nxt.pm * tstep + (size_t)nxt.koff * 2 : cA; const char* nB = has_next ? (const char*)g.Bt + (size_t)nxt.pn * tstep + (size_t)nxt.koff * 2 : cB;
        const int nt = cur.nt;
        for (int t = 0; t < nt; t += 2) {
            const bool last = (t == nt - 2);
            const char* a1 = cA + (size_t)(t + 1) * kstep;
            const char* a2 = last ? nA : cA + (size_t)(t + 2) * kstep; const char* b2 = last ? nB : cB + (size_t)(t + 2) * kstep;
            const char* a3 = a2 + kstep; const char* b3 = b2 + kstep;
            if (last && has_next) S.a_ready(nxt);
            if constexpr (SP2) {
            PG8_LDB(B0, 0, 0); PG8_LDB(B1, 0, 1); PG8_SCHED; PG8_LDA(At, 0, 0); PG8_STAGE(PG8_SA(1, 1), a1 + hstep, voffA);
            PG8_WAIT_V(8); PG8_WAIT_L(0); PG8_BAR; PG8_MMA(0, 0, At, B0); PG8_MMA(0, 1, At, B1); PG8_BAR; PG8_SCHED;
            PG8_LDA(At, 0, 1); PG8_STAGE(PG8_SB(0, 0), b2, voffB); PG8_STAGE(PG8_SB(0, 1), b2 + hstep, voffB); PG8_STAGE(PG8_SA(0, 0), a2, voffA);
            PG8_WAIT_V(8); PG8_WAIT_L(0); PG8_BAR; PG8_MMA(1, 0, At, B0); PG8_MMA(1, 1, At, B1); PG8_BAR; PG8_SCHED;
            PG8_LDB(B0, 1, 0); PG8_LDB(B1, 1, 1); PG8_SCHED; PG8_LDA(At, 1, 0); PG8_STAGE(PG8_SA(0, 1), a2 + hstep, voffA);
            PG8_WAIT_V(8); PG8_WAIT_L(0); PG8_BAR; PG8_MMA(0, 0, At, B0); PG8_MMA(0, 1, At, B1); PG8_BAR; PG8_SCHED;
            PG8_LDA(At, 1, 1); PG8_STAGE(PG8_SB(1, 0), b3, voffB); PG8_STAGE(PG8_SB(1, 1), b3 + hstep, voffB); PG8_STAGE(PG8_SA(1, 0), a3, voffA);
            PG8_WAIT_V(8); PG8_WAIT_L(0); PG8_BAR; PG8_MMA(1, 0, At, B0); PG8_MMA(1, 1, At, B1); PG8_BAR; PG8_SCHED;
            } else {
            PG8_LDB(B0, 0, 0); PG8_SCHED; PG8_LDA(At, 0, 0); PG8_STAGE(PG8_SA(1, 1), a1 + hstep, voffA);
            PG8_WAIT_L(8); PG8_BAR; PG8_WAIT_L(0); PG8_MMA(0, 0, At, B0); PG8_BAR; PG8_SCHED;
            PG8_LDB(B1, 0, 1); PG8_STAGE(PG8_SB(0, 0), b2, voffB);
            PG8_BAR; PG8_WAIT_L(0); PG8_MMA(0, 1, At, B1); PG8_BAR;
            PG8_LDA(At, 0, 1); PG8_STAGE(PG8_SA(0, 0), a2, voffA);
            PG8_BAR; PG8_WAIT_L(0); PG8_MMA(1, 0, At, B0); PG8_BAR; PG8_SCHED;
            PG8_STAGE(PG8_SB(0, 1), b2 + hstep, voffB);
            PG8_WAIT_V(6); PG8_BAR; PG8_MMA(1, 1, At, B1); PG8_BAR;
            PG8_LDB(B0, 1, 0); PG8_SCHED; PG8_LDA(At, 1, 0); PG8_STAGE(PG8_SA(0, 1), a2 + hstep, voffA);
            PG8_WAIT_L(8); PG8_BAR; PG8_WAIT_L(0); PG8_MMA(0, 0, At, B0); PG8_BAR; PG8_SCHED;
            PG8_LDB(B1, 1, 1); PG8_STAGE(PG8_SB(1, 0), b3, voffB);
            PG8_BAR; PG8_WAIT_L(0); PG8_MMA(0, 1, At, B1); PG8_BAR;
            PG8_LDA(At, 1, 1); PG8_STAGE(PG8_SA(1, 0), a3, voffA);
            PG8_BAR; PG8_WAIT_L(0); PG8_MMA(1, 0, At, B0); PG8_BAR; PG8_SCHED;
            PG8_STAGE(PG8_SB(1, 1), b3 + hstep, voffB);
            PG8_WAIT_V(6); PG8_BAR; PG8_MMA(1, 1, At, B1); PG8_BAR;
            }
        }
        if constexpr (ALIGN_EPI) { if (wr == 0) PG8_BAR; }
        if constexpr (!Epi::AFTER_DRAIN) { E(acc, cur, wr, wc, fr, fq); S.done(cur); }
        if (!has_next) break;
#pragma unroll
        for (int a = 0; a < 2; ++a)
#pragma unroll
            for (int b = 0; b < 2; ++b)
#pragma unroll
                for (int m = 0; m < 4; ++m)
#pragma unroll
                    for (int n = 0; n < 2; ++n) acc[a][b][m][n] = (f32x4){0.f, 0.f, 0.f, 0.f};
        cur = nxt; cA = nA; cB = nB; ++ui;
        if constexpr (ALIGN_EPI) { if (wr == 1) PG8_BAR; }
    }
    PG8_WAIT_V(0);
    if constexpr (!ALIGN_EPI) { if (wr == 0) PG8_BAR; }
    PG8_BAR;
    if constexpr (Epi::AFTER_DRAIN) { E.fused(acc, cur, wr, wc, fr, fq, lds, wid, lane); S.done(cur); }
#undef PG8_SA
#undef PG8_SB
#undef PG8_STAGE
#undef PG8_LDA
#undef PG8_LDB
#undef PG8_MMA
#undef PG8_WAIT_V
#undef PG8_WAIT_L
#undef PG8_BAR
#undef PG8_SCHED
}
}
#define LAS __attribute__((address_space(3)))
typedef unsigned short bf16;
typedef short bf16x8 __attribute__((ext_vector_type(8)));
typedef short s16x4 __attribute__((ext_vector_type(4)));
typedef float f32x4 __attribute__((ext_vector_type(4)));
typedef float f32x16 __attribute__((ext_vector_type(16)));
typedef unsigned u32x4 __attribute__((ext_vector_type(4)));
typedef unsigned u32x2 __attribute__((ext_vector_type(2)));
#define DI __device__ __forceinline__
#define MFMA32(a, b, c) __builtin_amdgcn_mfma_f32_32x32x16_bf16((a), (b), (c), 0, 0, 0)

DI unsigned f2bf(float f) { unsigned u = __builtin_bit_cast(unsigned, f); return (u + 0x7fffu + ((u >> 16) & 1u)) >> 16; }
typedef __bf16 bf16x2_t __attribute__((ext_vector_type(2)));
typedef float f32x2_t __attribute__((ext_vector_type(2)));
DI unsigned pk2(float lo, float hi) { const f32x2_t v = {lo, hi}; const bf16x2_t b = __builtin_convertvector(v, bf16x2_t); return __builtin_bit_cast(unsigned, b); }
DI float bflo(unsigned w) { return __builtin_bit_cast(float, w << 16); }
DI float bfhi(unsigned w) { return __builtin_bit_cast(float, w & 0xffff0000u); }
DI float wave_sum(float v) {
#pragma unroll
    for (int o = 1; o < 64; o <<= 1) v += __shfl_xor(v, o);
    return v;
}

constexpr int DM = 2048, NPT = 8192, NTOK = 12288, NKV = 14336, FFD = 8192, ABP = 4352;
constexpr float EPSF = 1e-6f, LOG2E = 1.4426950408889634f;
constexpr int NWAVES = 8, NTHR = 512;
constexpr size_t MiB = 1u << 20;
constexpr size_t WS_WIN0 = 0;
constexpr size_t WS_WQUP = 17 * MiB;
constexpr size_t WS_WKVUP = WS_WQUP + 1536 * 512 * 2;
constexpr size_t WS_WOUT0 = WS_WKVUP + 2048 * 512 * 2;
constexpr size_t WS_WFF1 = WS_WOUT0 + 8 * MiB;
constexpr size_t WS_WFF2 = WS_WFF1 + 64 * MiB;
constexpr size_t WS_WCIN = WS_WFF2 + 64 * MiB;
constexpr size_t WS_WCOUT = WS_WCIN + 12 * MiB;
constexpr size_t WS_MOD = WS_WCOUT + 8 * MiB;
constexpr size_t WS_TAB = WS_MOD + 512 * 1024;
constexpr size_t WS_XA = WS_TAB + 512 * 1024;
constexpr size_t WS_XB = WS_XA + 96 * MiB;
constexpr size_t WS_H = WS_XB + 96 * MiB;
constexpr size_t WS_R = WS_H + 48 * MiB;
constexpr size_t WS_RAW = WS_R;
constexpr size_t WS_RAW2 = WS_R;
constexpr size_t WS_RAW3 = WS_R + 36 * MiB;
constexpr size_t WS_QDA = WS_R + 102 * MiB;
constexpr size_t WS_KDA = WS_QDA + 24 * MiB;
constexpr size_t WS_VDA = WS_KDA + 28 * MiB;
constexpr size_t WS_MQN = WS_VDA + 28 * MiB;
constexpr size_t WS_CKV = WS_MQN + 12 * MiB;
constexpr size_t WS_VMLA = WS_CKV + 14 * MiB;
constexpr size_t WS_KR = WS_VMLA + 28 * MiB;
constexpr size_t WS_PART = WS_KR + 4 * MiB;
constexpr size_t WS_FLAGS = WS_PART + 32 * MiB;
constexpr size_t WS_BAR = WS_FLAGS + 64 * 1024;
constexpr size_t WS_END = WS_FLAGS + 1 * MiB;
constexpr size_t WS_QMLA = WS_XB;
constexpr size_t WS_KMLA = WS_XB + 36 * MiB;
constexpr size_t WS_FFH = WS_R;
constexpr size_t WS_RAWC = WS_R;
constexpr size_t WS_QC = WS_R + 72 * MiB;
constexpr size_t WS_KC = WS_QC + 48 * MiB;
constexpr size_t WS_VC = WS_KC + 14 * MiB;
static_assert(WS_END <= 768 * MiB && WS_FFH + 192 * MiB <= WS_END, "ws map");
constexpr int TB_C16 = 0, TB_S16 = 1024, TB_C32 = 2048, TB_S32 = 4096, TB_LAM = 6144;
constexpr size_t OUT_Y = 0, OUT_DAK = 25165824, OUT_DAV = 33554432, OUT_CKV = 41943040, OUT_KR = 46137344, OUT_GQK = 46661632, OUT_GQV = 50855936;
constexpr int LDS_BYTES = 147456;

struct Args { const float* in[36]; float* out; unsigned char* ws; int ph_lo, ph_hi, coop, pad; };

DI int kvrow_of(int r) { if (r < NPT) return r; const int s = r - NPT; return NPT + (s >> 10) * 1536 + 512 + (s & 1023); }

struct TrDesc { const float* W; bf16* WT; int K, N, item; };
DI void tr_load(const TrDesc& d, f32x4 (&v)[4], int tid) {
    const int nblk = d.N / 64, kb = d.item / nblk, nb = d.item % nblk, k0 = kb * 128, n0 = nb * 64;
    const int kr = tid >> 4, nc = (tid & 15) * 4;
#pragma unroll
    for (int p = 0; p < 4; ++p) v[p] = __builtin_nontemporal_load((const f32x4*)(d.W + (size_t)(k0 + kr + 32 * p) * d.N + n0 + nc));
}
DI void tr_store(const TrDesc& d, const f32x4 (&v)[4], LAS float* T, int tid) {
    const int nblk = d.N / 64, kb = d.item / nblk, nb = d.item % nblk, k0 = kb * 128, n0 = nb * 64;
    const int kr = tid >> 4, nc = (tid & 15) * 4;
#pragma unroll
    for (int p = 0; p < 4; ++p) { const int k = kr + 32 * p; T[k * 65 + nc] = v[p].x; T[k * 65 + nc + 1] = v[p].y; T[k * 65 + nc + 2] = v[p].z; T[k * 65 + nc + 3] = v[p].w; }
    __syncthreads();
#pragma unroll
    for (int i = 0; i < 2; ++i) { const int it = tid + 512 * i, kc = it & 15, n = it >> 4; const LAS float* s = T + (kc * 8) * 65 + n;
        u32x4 o; o.x = pk2(s[0], s[65]); o.y = pk2(s[130], s[195]); o.z = pk2(s[260], s[325]); o.w = pk2(s[390], s[455]);
        *(u32x4*)(d.WT + (size_t)(n0 + n) * d.K + k0 + kc * 8) = o; }
}

DI void ada_unit(const Args& a, int l, int u, LAS float* L, int tid) {
    const int col0 = u * 48;
    LAS float* S = L; LAS float* RED = L + 5 * 2048;
    for (int i = tid; i < 5 * 2048; i += NTHR) { const int c = i >> 11, k = i & 2047; const float v = (c == 0) ? a.in[9][k] : a.in[8][(c - 1) * 2048 + k]; S[i] = v / (1.f + __expf(-v)); }
    __syncthreads();
    const int c4 = tid % 12, kg = tid / 12;
    if (kg < 32) {
        float acc[5][4];
#pragma unroll
        for (int c = 0; c < 5; ++c)
#pragma unroll
            for (int j = 0; j < 4; ++j) acc[c][j] = 0.f;
        const float* wp = a.in[12] + (size_t)l * 2048 * 12288 + (size_t)(kg * 64) * 12288 + col0 + c4 * 4;
#pragma unroll 1
        for (int k0 = 0; k0 < 64; k0 += 16) {
            f32x4 w[16];
#pragma unroll
            for (int kk = 0; kk < 16; ++kk) w[kk] = __builtin_nontemporal_load((const f32x4*)(wp + (size_t)(k0 + kk) * 12288));
#pragma unroll
            for (int kk = 0; kk < 16; ++kk)
#pragma unroll
                for (int c = 0; c < 5; ++c) { const float s = S[c * 2048 + kg * 64 + k0 + kk];
#pragma unroll
                    for (int j = 0; j < 4; ++j) acc[c][j] += s * w[kk][j]; }
        }
#pragma unroll
        for (int c = 0; c < 5; ++c)
#pragma unroll
            for (int j = 0; j < 4; ++j) RED[(kg * 5 + c) * 48 + c4 * 4 + j] = acc[c][j];
    }
    __syncthreads();
    float* MOD = (float*)(a.ws + WS_MOD);
    if (tid < 240) { const int c = tid / 48, col = tid % 48; float s = 0.f;
#pragma unroll
        for (int g = 0; g < 32; ++g) s += RED[(g * 5 + c) * 48 + col];
        MOD[(size_t)(l * 5 + c) * 12288 + col0 + col] = s + a.in[13][l * 12288 + col0 + col]; }
    __syncthreads();
}

DI void misc_unit(const Args& a, int tid) {
    float* TB = (float*)(a.ws + WS_TAB);
    for (int idx = tid; idx < 64 * 16 + 64 * 32; idx += NTHR) {
        int half, pos, i, oc, os;
        if (idx < 1024) { half = 16; pos = idx >> 4; i = idx & 15; oc = TB_C16 + idx; os = TB_S16 + idx; }
        else { const int j = idx - 1024; half = 32; pos = j >> 5; i = j & 31; oc = TB_C32 + j; os = TB_S32 + j; }
        const float inv = exp2f(-((float)i / (float)half) * 13.287712379549449f);
        const float ang = (float)pos * inv;
        const float n = rintf(ang * 0.15915494309189535f);
        float r = fmaf(-n, 6.2831854820251465f, ang); r = fmaf(n, 1.7484556000744883e-07f, r);
        TB[oc] = __cosf(r); TB[os] = __sinf(r);
    }
    if (tid == 0) { float s1 = 0.f, s2 = 0.f;
        for (int i = 0; i < 64; ++i) { s1 += a.in[18][i] * a.in[19][i]; s2 += a.in[20][i] * a.in[21][i]; }
        TB[TB_LAM] = expf(s1) - expf(s2) + 0.2f; }
}

constexpr int CI_A = 1264, CI_B = 4848, CI_C = 7664, CI_END = 11248;
DI TrDesc tr_decode(const Args& a, int r) {
    unsigned char* ws = a.ws;
    if (r < 1040) return TrDesc{a.in[16], (bf16*)(ws + WS_WIN0), 2048, 4160, r}; r -= 1040;
    if (r < 96) return TrDesc{a.in[26], (bf16*)(ws + WS_WQUP), 512, 1536, r}; r -= 96;
    if (r < 128) return TrDesc{a.in[28], (bf16*)(ws + WS_WKVUP), 512, 2048, r}; r -= 128;
    if (r < 2048) return TrDesc{a.in[14], (bf16*)(ws + WS_WFF1), 2048, 8192, r}; r -= 2048;
    if (r < 512) return TrDesc{a.in[17], (bf16*)(ws + WS_WOUT0), 2048, 2048, r}; r -= 512;
    if (r < 1024) return TrDesc{a.in[15] + (size_t)2048 * 8192, (bf16*)(ws + WS_WFF2) + (size_t)8192 * 2048, 8192, 2048, r}; r -= 1024;
    if (r < 2048) return TrDesc{a.in[15], (bf16*)(ws + WS_WFF2), 8192, 2048, r}; r -= 2048;
    if (r < 768) return TrDesc{a.in[31], (bf16*)(ws + WS_WCIN), 2048, 3072, r}; r -= 768;
    if (r < 512) return TrDesc{a.in[32], (bf16*)(ws + WS_WCOUT), 2048, 2048, r}; r -= 512;
    if (r < 2048) return TrDesc{a.in[14] + (size_t)2048 * 8192, (bf16*)(ws + WS_WFF1) + (size_t)8192 * 2048, 2048, 8192, r}; r -= 2048;
    return TrDesc{a.in[15] + (size_t)2048 * 8192, (bf16*)(ws + WS_WFF2) + (size_t)8192 * 2048, 8192, 2048, r + 1024};
}
DI void convert_items(const Args& a, LAS unsigned char* lds, int tid, int first, int stride, int lo, int hi) {
    LAS float* L = (LAS float*)lds;
    int it = lo + first, par = 0;
    if (it >= hi) return;
    __syncthreads();
    TrDesc cur = tr_decode(a, it);
    f32x4 v[4];
    tr_load(cur, v, tid);
    for (; it < hi; it += stride) {
        const int nit = it + stride;
        TrDesc nxt = cur; f32x4 nv[4];
        if (nit < hi) { nxt = tr_decode(a, nit); tr_load(nxt, nv, tid); }
        tr_store(cur, v, L + par * (128 * 65), tid); par ^= 1;
        if (nit < hi) { cur = nxt;
#pragma unroll
            for (int p = 0; p < 4; ++p) v[p] = nv[p]; }
    }
    __syncthreads();
}
DI void bg_convert(const Args& a, LAS unsigned char* lds, int tid, int G, int nwg, int lo, int hi) {
    const int rem = nwg % G, c = (int)blockIdx.x;
    if (rem == 0) convert_items(a, lds, tid, c, G, lo, hi);
    else if (c >= rem) convert_items(a, lds, tid, c - rem, G - rem, lo, hi);
}
DI void phase0(const Args& a, LAS unsigned char* lds, int tid, int G) {
    LAS float* L = (LAS float*)lds;
    const int c = (int)blockIdx.x;
    if (c == 0) { ((unsigned*)(a.ws + WS_FLAGS))[tid] = 0u; for (int i = tid; i < 3456; i += NTHR) ((unsigned*)(a.ws + WS_BAR))[i] = 0u; }
    convert_items(a, lds, tid, c, G, 0, CI_A);
    for (int it = c; it < 513; it += G) { if (it < 512) ada_unit(a, it >> 8, it & 255, L, tid); else misc_unit(a, tid); }
}
DI void bg_ada1(const Args& a, LAS unsigned char* lds, int tid, int G, int nwg) {
    const int rem = nwg % G, c = (int)blockIdx.x;
    const int first = rem == 0 ? c : c - rem, stride = rem == 0 ? G : G - rem;
    if (first < 0) return;
    for (int it = first; it < 256; it += stride) ada_unit(a, 1, it, (LAS float*)lds, tid);
}

DI void norm_phase(const float* xp, const float* xs  , const float* g, const float* mod_l  , int sh_off, int sc_off, bf16* H, int tid, int G) {
    const int lane = tid & 63, wave = tid >> 6;
    f32x4 gg[8];
#pragma unroll
    for (int j = 0; j < 8; ++j) gg[j] = *(const f32x4*)(g + 4 * lane + 256 * j);
    for (int row = blockIdx.x * NWAVES + wave; row < NTOK; row += G * NWAVES) {
        const float* x = (row < NPT ? xp : xs) + (size_t)row * DM;
        const int cond = row < NPT ? 0 : 1 + ((row - NPT) >> 10);
        const float* md = mod_l + (size_t)cond * 12288;
        f32x4 v[8], sc[8], sh[8]; float ss = 0.f;
#pragma unroll
        for (int j = 0; j < 8; ++j) v[j] = *(const f32x4*)(x + 4 * lane + 256 * j);
#pragma unroll
        for (int j = 0; j < 8; ++j) { sc[j] = *(const f32x4*)(md + sc_off + 4 * lane + 256 * j); sh[j] = *(const f32x4*)(md + sh_off + 4 * lane + 256 * j); }
#pragma unroll
        for (int j = 0; j < 8; ++j) ss += v[j].x * v[j].x + v[j].y * v[j].y + v[j].z * v[j].z + v[j].w * v[j].w;
        ss = wave_sum(ss);
        const float rs = rsqrtf(ss * (1.f / DM) + EPSF);
#pragma unroll
        for (int j = 0; j < 8; ++j) { const int col = 4 * lane + 256 * j;
            const f32x4 y = v[j] * rs * gg[j] * (sc[j] + 1.f) + sh[j];
            u32x2 o; o.x = pk2(y.x, y.y); o.y = pk2(y.z, y.w);
            *(u32x2*)(H + (size_t)row * DM + col) = o; }
    }
}
DI void ld16(const bf16* p, float (&v)[16]) {
    const u32x4 w0 = *(const u32x4*)p, w1 = *(const u32x4*)(p + 8);
    v[0] = bflo(w0.x); v[1] = bfhi(w0.x); v[2] = bflo(w0.y); v[3] = bfhi(w0.y); v[4] = bflo(w0.z); v[5] = bfhi(w0.z); v[6] = bflo(w0.w); v[7] = bfhi(w0.w);
    v[8] = bflo(w1.x); v[9] = bfhi(w1.x); v[10] = bflo(w1.y); v[11] = bfhi(w1.y); v[12] = bflo(w1.z); v[13] = bfhi(w1.z); v[14] = bflo(w1.w); v[15] = bfhi(w1.w);
}
DI void ld8(const bf16* p, float (&v)[8]) {
    const u32x4 w0 = *(const u32x4*)p;
    v[0] = bflo(w0.x); v[1] = bfhi(w0.x); v[2] = bflo(w0.y); v[3] = bfhi(w0.y); v[4] = bflo(w0.z); v[5] = bfhi(w0.z); v[6] = bflo(w0.w); v[7] = bfhi(w0.w);
}
DI void st16bf(bf16* p, const float (&v)[16]) {
    u32x4 w0, w1; w0.x = pk2(v[0], v[1]); w0.y = pk2(v[2], v[3]); w0.z = pk2(v[4], v[5]); w0.w = pk2(v[6], v[7]);
    w1.x = pk2(v[8], v[9]); w1.y = pk2(v[10], v[11]); w1.z = pk2(v[12], v[13]); w1.w = pk2(v[14], v[15]);
    *(u32x4*)p = w0; *(u32x4*)(p + 8) = w1;
}
DI void st8bf(bf16* p, const float (&v)[8]) {
    u32x4 w0; w0.x = pk2(v[0], v[1]); w0.y = pk2(v[2], v[3]); w0.z = pk2(v[4], v[5]); w0.w = pk2(v[6], v[7]);
    *(u32x4*)p = w0;
}
DI void st16f(float* p, const float (&v)[16]) {
#pragma unroll
    for (int j = 0; j < 4; ++j) *(f32x4*)(p + 4 * j) = (f32x4){v[4 * j], v[4 * j + 1], v[4 * j + 2], v[4 * j + 3]};
}
DI void st8f(float* p, const float (&v)[8]) {
    *(f32x4*)p = (f32x4){v[0], v[1], v[2], v[3]}; *(f32x4*)(p + 4) = (f32x4){v[4], v[5], v[6], v[7]};
}
DI void ld8f(const float* p, float (&v)[8]) { const f32x4 a = *(const f32x4*)p, b = *(const f32x4*)(p + 4); v[0] = a.x; v[1] = a.y; v[2] = a.z; v[3] = a.w; v[4] = b.x; v[5] = b.y; v[6] = b.z; v[7] = b.w; }
DI void ld16f(const float* p, float (&v)[16]) {
#pragma unroll
    for (int j = 0; j < 4; ++j) { const f32x4 a = *(const f32x4*)(p + 4 * j); v[4 * j] = a.x; v[4 * j + 1] = a.y; v[4 * j + 2] = a.z; v[4 * j + 3] = a.w; }
}
DI void cv16(const u32x4& w0, const u32x4& w1, float (&v)[16]) {
    v[0] = bflo(w0.x); v[1] = bfhi(w0.x); v[2] = bflo(w0.y); v[3] = bfhi(w0.y); v[4] = bflo(w0.z); v[5] = bfhi(w0.z); v[6] = bflo(w0.w); v[7] = bfhi(w0.w);
    v[8] = bflo(w1.x); v[9] = bfhi(w1.x); v[10] = bflo(w1.y); v[11] = bfhi(w1.y); v[12] = bflo(w1.z); v[13] = bfhi(w1.z); v[14] = bflo(w1.w); v[15] = bfhi(w1.w);
}
DI void cv8(const u32x4& w0, float (&v)[8]) {
    v[0] = bflo(w0.x); v[1] = bfhi(w0.x); v[2] = bflo(w0.y); v[3] = bfhi(w0.y); v[4] = bflo(w0.z); v[5] = bfhi(w0.z); v[6] = bflo(w0.w); v[7] = bfhi(w0.w);
}
template <int N> DI void rope_apply(float (&y)[N], int px, const float (&tc)[N], const float (&ts)[N], bool is_x2, bool active) {
#pragma unroll
    for (int j = 0; j < N; ++j) { const float py = __shfl_xor(y[j], px); if (active) { const float c = tc[j], s = ts[j]; y[j] = is_x2 ? y[j] * c + py * s : y[j] * c - py * s; } }
}

DI void postA_phase(const Args& a, int tid, int G) {
    unsigned char* ws = a.ws;
    const bf16* RAW = (const bf16*)(ws + WS_RAW);
    bf16 *QDA = (bf16*)(ws + WS_QDA), *KDA = (bf16*)(ws + WS_KDA), *VDA = (bf16*)(ws + WS_VDA), *MQN = (bf16*)(ws + WS_MQN), *CKV = (bf16*)(ws + WS_CKV);
    float* KR = (float*)(ws + WS_KR); const float* TB = (const float*)(ws + WS_TAB);
    const int lane = tid & 63, wave = tid >> 6;
    const int sub = lane & 3;
    float gq[16], gk[16], gmq[8], gmkv[8];
    ld16f(a.in[22] + 16 * sub, gq); ld16f(a.in[23] + 16 * sub, gk); ld8f(a.in[25] + 8 * lane, gmq); ld8f(a.in[27] + 8 * lane, gmkv);
    for (int r = blockIdx.x * NWAVES + wave; r < NTOK + 2048; r += G * NWAVES) {
        if (r < NTOK) {
            const bool isS = r >= NPT; const int t = (r - NPT) & 1023; const int prow = t >> 6, pcol = t & 63;
            const int kvr = kvrow_of(r);
            const bf16* raw = RAW + (size_t)r * ABP;
            const int pos = (sub < 2) ? prow : pcol;
            float tc[16], ts[16];
            if (isS) { ld16f(TB + TB_C16 + pos * 16, tc); ld16f(TB + TB_S16 + pos * 16, ts); }
            else {
#pragma unroll
                for (int j = 0; j < 16; ++j) { tc[j] = 1.f; ts[j] = 0.f; } }
            float v[16];
            const u32x4 rq0 = *(const u32x4*)(raw + 16 * lane), rq1 = *(const u32x4*)(raw + 16 * lane + 8);
            const u32x4 rk0 = *(const u32x4*)(raw + 1024 + 16 * lane), rk1 = *(const u32x4*)(raw + 1024 + 16 * lane + 8);
            const u32x4 rmq = *(const u32x4*)(raw + 3072 + 8 * lane), rmkv = *(const u32x4*)(raw + 3584 + 8 * lane);
            const unsigned short rkr = raw[4096 + lane];
            cv16(rq0, rq1, v);
            { float ss = 0.f;
#pragma unroll
              for (int j = 0; j < 16; ++j) ss += v[j] * v[j];
              ss += __shfl_xor(ss, 1); ss += __shfl_xor(ss, 2); const float rs = rsqrtf(ss * (1.f / 64.f) + EPSF);
#pragma unroll
              for (int j = 0; j < 16; ++j) v[j] = v[j] * rs * gq[j]; }
            rope_apply<16>(v, 1, tc, ts, (sub & 1) != 0, isS);
            st16bf(QDA + (size_t)r * 1024 + 16 * lane, v);
            cv16(rk0, rk1, v);
            { float ss = 0.f;
#pragma unroll
              for (int j = 0; j < 16; ++j) ss += v[j] * v[j];
              ss += __shfl_xor(ss, 1); ss += __shfl_xor(ss, 2); const float rs = rsqrtf(ss * (1.f / 64.f) + EPSF);
#pragma unroll
              for (int j = 0; j < 16; ++j) v[j] = v[j] * rs * gk[j]; }
            if (!isS) st16f(a.out + OUT_DAK + (size_t)r * 1024 + 16 * lane, v);
            rope_apply<16>(v, 1, tc, ts, (sub & 1) != 0, isS);
            st16bf(KDA + (size_t)kvr * 1024 + 16 * lane, v);
            float w[8];
            cv8(rmq, w);
            { float ss = 0.f;
#pragma unroll
              for (int j = 0; j < 8; ++j) ss += w[j] * w[j];
              ss = wave_sum(ss); const float rs = rsqrtf(ss * (1.f / 512.f) + EPSF);
#pragma unroll
              for (int j = 0; j < 8; ++j) w[j] = w[j] * rs * gmq[j]; }
            st8bf(MQN + (size_t)r * 512 + 8 * lane, w);
            cv8(rmkv, w);
            { float ss = 0.f;
#pragma unroll
              for (int j = 0; j < 8; ++j) ss += w[j] * w[j];
              ss = wave_sum(ss); const float rs = rsqrtf(ss * (1.f / 512.f) + EPSF);
#pragma unroll
              for (int j = 0; j < 8; ++j) w[j] = w[j] * rs * gmkv[j]; }
            st8bf(CKV + (size_t)kvr * 512 + 8 * lane, w);
            if (!isS) st8f(a.out + OUT_CKV + (size_t)r * 512 + 8 * lane, w);
            { const float kr = __builtin_bit_cast(float, (unsigned)rkr << 16);
              KR[(size_t)kvr * 64 + lane] = kr; if (!isS) a.out[OUT_KR + (size_t)r * 64 + lane] = kr; }
        } else {
            const int c = r - NTOK, b = c >> 9, p = c & 511; const int kvr = NPT + b * 1536 + p;
            float v[16], v2[16], w[8];
            ld16f(a.in[2] + (size_t)c * 1024 + 16 * lane, v); ld16f(a.in[3] + (size_t)c * 1024 + 16 * lane, v2); ld8f(a.in[4] + (size_t)c * 512 + 8 * lane, w);
            const float krv = a.in[5][(size_t)c * 64 + lane];
            st16bf(KDA + (size_t)kvr * 1024 + 16 * lane, v); st16bf(VDA + (size_t)kvr * 1024 + 16 * lane, v2);
            st8bf(CKV + (size_t)kvr * 512 + 8 * lane, w);
            KR[(size_t)kvr * 64 + lane] = krv;
        }
    }
}

DI void postB_phase(const Args& a, int tid, int G) {
    unsigned char* ws = a.ws;
    const bf16* RAW2 = (const bf16*)(ws + WS_RAW2); const bf16* RAW3 = (const bf16*)(ws + WS_RAW3);
    bf16 *QM = (bf16*)(ws + WS_QMLA), *KM = (bf16*)(ws + WS_KMLA), *VM = (bf16*)(ws + WS_VMLA);
    const float* KR = (const float*)(ws + WS_KR); const float* TB = (const float*)(ws + WS_TAB);
    const int lane = tid & 63, wave = tid >> 6, half = lane >> 5, li = lane & 31;
    const int cidx = li - 16;
    const bool ropelane = li >= 16 && li < 24;
    float gqn[8], gkn[8];
#pragma unroll
    for (int j = 0; j < 8; ++j) { gqn[j] = 0.f; gkn[j] = 0.f; }
    if (li < 24) { ld8f(a.in[29] + 8 * li, gqn); ld8f(a.in[30] + 8 * li, gkn); }
    for (int r = blockIdx.x * NWAVES + wave; r < NTOK + NKV; r += G * NWAVES) {
        if (r < NTOK) {
            const bool isS = r >= NPT; const int t = (r - NPT) & 1023; const int prow = t >> 6, pcol = t & 63;
            const int pos = (cidx < 4) ? prow : pcol;
            float tc[8], ts[8];
            if (isS) { ld8f(TB + TB_C16 + pos * 16 + 8 * (cidx & 1), tc); ld8f(TB + TB_S16 + pos * 16 + 8 * (cidx & 1), ts); }
            else {
#pragma unroll
                for (int j = 0; j < 8; ++j) { tc[j] = 1.f; ts[j] = 0.f; } }
            u32x4 rw[4];
#pragma unroll
            for (int it = 0; it < 4; ++it) { rw[it] = (u32x4){0u, 0u, 0u, 0u}; if (li < 24) rw[it] = *(const u32x4*)(RAW2 + (size_t)r * 1536 + (it * 2 + half) * 192 + 8 * li); }
#pragma unroll
            for (int it = 0; it < 4; ++it) { const int head = it * 2 + half;
                float w[8];
                cv8(rw[it], w);
                float ss = 0.f;
#pragma unroll
                for (int j = 0; j < 8; ++j) ss += w[j] * w[j];
#pragma unroll
                for (int o = 1; o < 32; o <<= 1) ss += __shfl_xor(ss, o);
                const float rs = rsqrtf(ss * (1.f / 192.f) + EPSF);
                if (li < 24) {
#pragma unroll
                    for (int j = 0; j < 8; ++j) w[j] = w[j] * rs * gqn[j]; }
                rope_apply<8>(w, 2, tc, ts, (cidx & 2) != 0, isS && ropelane);
                if (li < 24) st8bf(QM + (size_t)r * 1536 + head * 192 + 8 * li, w);
            }
        } else {
            const int kvr = r - NTOK;
            const int sj = (kvr - NPT) % 1536; const bool lat = kvr >= NPT && sj >= 512; const int t = sj - 512; const int prow = (t >> 6) & 15, pcol = t & 63;
            const int pos = (cidx < 4) ? prow : pcol;
            float tc[8], ts[8];
            if (lat) { ld8f(TB + TB_C16 + pos * 16 + 8 * (cidx & 1), tc); ld8f(TB + TB_S16 + pos * 16 + 8 * (cidx & 1), ts); }
            else {
#pragma unroll
                for (int j = 0; j < 8; ++j) { tc[j] = 1.f; ts[j] = 0.f; } }
            float kr[8];
#pragma unroll
            for (int j = 0; j < 8; ++j) kr[j] = 0.f;
            if (ropelane) ld8f(KR + (size_t)kvr * 64 + 8 * cidx, kr);
            u32x4 rk[4];
#pragma unroll
            for (int it = 0; it < 4; ++it) { rk[it] = (u32x4){0u, 0u, 0u, 0u};
                if (li < 16) rk[it] = *(const u32x4*)(RAW3 + (size_t)kvr * 2048 + (it * 2 + half) * 256 + 8 * li); }
#pragma unroll
            for (int it = 0; it < 4; ++it) { const int head = it * 2 + half;
                float w[8];
#pragma unroll
                for (int j = 0; j < 8; ++j) w[j] = kr[j];
                if (li < 16) cv8(rk[it], w);
                float ss = 0.f;
#pragma unroll
                for (int j = 0; j < 8; ++j) ss += w[j] * w[j];
#pragma unroll
                for (int o = 1; o < 32; o <<= 1) ss += __shfl_xor(ss, o);
                const float rs = rsqrtf(ss * (1.f / 192.f) + EPSF);
                if (li < 24) {
#pragma unroll
                    for (int j = 0; j < 8; ++j) w[j] = w[j] * rs * gkn[j]; }
                rope_apply<8>(w, 2, tc, ts, (cidx & 2) != 0, lat && ropelane);
                if (li < 24) st8bf(KM + (size_t)kvr * 1536 + head * 192 + 8 * li, w);
            }
        }
    }
}

DI void postC_phase(const Args& a, int tid, int G) {
    unsigned char* ws = a.ws;
    const bf16* RAWC = (const bf16*)(ws + WS_RAWC);
    bf16 *QC = (bf16*)(ws + WS_QC), *KC = (bf16*)(ws + WS_KC), *VC = (bf16*)(ws + WS_VC);
    const float* TB = (const float*)(ws + WS_TAB);
    const int lane = tid & 63, wave = tid >> 6, sub = lane & 7;
    float gqc[16], gkc[16];
    ld16f(a.in[33] + 16 * sub, gqc); ld16f(a.in[34] + 16 * sub, gkc);
    for (int r = blockIdx.x * NWAVES + wave; r < NTOK + 2048; r += G * NWAVES) {
        if (r < NTOK) {
            const bool isS = r >= NPT; const int t = (r - NPT) & 1023; const int prow = t >> 6, pcol = t & 63;
            const int kvr = kvrow_of(r);
            const bf16* raw = RAWC + (size_t)r * 3072;
            const int pos = (sub < 4) ? prow : pcol;
            float tc[16], ts[16];
            if (isS) { ld16f(TB + TB_C32 + pos * 32 + 16 * (sub & 1), tc); ld16f(TB + TB_S32 + pos * 32 + 16 * (sub & 1), ts); }
            else {
#pragma unroll
                for (int j = 0; j < 16; ++j) { tc[j] = 1.f; ts[j] = 0.f; } }
            float v[16];
            u32x4 rr[3][2];
#pragma unroll
            for (int p = 0; p < 3; ++p) { rr[p][0] = *(const u32x4*)(raw + p * 1024 + 16 * lane); rr[p][1] = *(const u32x4*)(raw + p * 1024 + 16 * lane + 8); }
#pragma unroll
            for (int p = 0; p < 2; ++p) {
                cv16(rr[p][0], rr[p][1], v);
                float ss = 0.f;
#pragma unroll
                for (int j = 0; j < 16; ++j) ss += v[j] * v[j];
                ss += __shfl_xor(ss, 1); ss += __shfl_xor(ss, 2); ss += __shfl_xor(ss, 4);
                const float rs = rsqrtf(ss * (1.f / 128.f) + EPSF);
#pragma unroll
                for (int j = 0; j < 16; ++j) v[j] = v[j] * rs * gqc[j];
                rope_apply<16>(v, 2, tc, ts, (sub & 2) != 0, isS);
                st16bf(QC + (size_t)r * 2048 + p * 1024 + 16 * lane, v);
            }
            cv16(rr[2][0], rr[2][1], v);
            const bool isk = lane < 32;
            { float ss = 0.f;
#pragma unroll
              for (int j = 0; j < 16; ++j) ss += v[j] * v[j];
              ss += __shfl_xor(ss, 1); ss += __shfl_xor(ss, 2); ss += __shfl_xor(ss, 4);
              const float rs = rsqrtf(ss * (1.f / 128.f) + EPSF);
              if (isk) {
#pragma unroll
                  for (int j = 0; j < 16; ++j) v[j] = v[j] * rs * gkc[j]; } }
            if (!isS && isk) st16f(a.out + OUT_GQK + (size_t)r * 512 + 16 * (lane & 31), v);
            rope_apply<16>(v, 2, tc, ts, (sub & 2) != 0, isS && isk);
            if (isk) st16bf(KC + (size_t)kvr * 512 + 16 * (lane & 31), v);
        } else {
            const int c = r - NTOK, b = c >> 9, p = c & 511; const int kvr = NPT + b * 1536 + p;
            float w[8];
            ld8f(a.in[6] + (size_t)c * 512 + 8 * lane, w); st8bf(KC + (size_t)kvr * 512 + 8 * lane, w);
            ld8f(a.in[7] + (size_t)c * 512 + 8 * lane, w); st8bf(VC + (size_t)kvr * 512 + 8 * lane, w);
        }
    }
}
constexpr int VT_LD = 72;
DI int crow(int i, int hi) { return (i & 3) + 8 * (i >> 2) + 4 * hi; }
DI float xmax32(float v) { const auto rr = __builtin_amdgcn_permlane32_swap(__builtin_bit_cast(unsigned, v), __builtin_bit_cast(unsigned, v), false, false); return fmaxf(__builtin_bit_cast(float, rr[0]), __builtin_bit_cast(float, rr[1])); }
DI float xsum32(float v) { const auto rr = __builtin_amdgcn_permlane32_swap(__builtin_bit_cast(unsigned, v), __builtin_bit_cast(unsigned, v), false, false); return __builtin_bit_cast(float, rr[0]) + __builtin_bit_cast(float, rr[1]); }

constexpr int KB_STRIDE = 25600, VT_BASE = 51200, VT_STRIDE = 20480, V_ROWB = 320;
typedef short v4i16_t __attribute__((ext_vector_type(4)));
DI s16x4 vtr(const LAS unsigned char* p) { return __builtin_bit_cast(s16x4, __builtin_amdgcn_ds_read_tr16_b64_v4i16((LAS v4i16_t*)p)); }
template <int DK, bool WINDOW>
DI void attn_core(f32x16 (&o)[4], const bf16* __restrict__ qp, const bf16* __restrict__ kbase, int kstride, const bf16* __restrict__ vbase, int vstride,
                  int nct, int lat_off, int nlt, float sl2, bool has_sink, float sinkl2, int q0, LAS unsigned char* lds, int tid) {
    constexpr int KS = DK + 8, NKS = DK / 16, NKC = DK / 64, CPR = DK / 8;
    const int lane = tid & 63, l32 = lane & 31, hi = lane >> 5;
    bf16x8 qf[NKS];
#pragma unroll
    for (int ks = 0; ks < NKS; ++ks) qf[ks] = *(const bf16x8*)(qp + ks * 16 + 8 * hi);
#pragma unroll
    for (int db = 0; db < 4; ++db)
#pragma unroll
        for (int i = 0; i < 16; ++i) o[db][i] = 0.f;
    const int vtr_off = (4 * hi + ((lane & 15) >> 2)) * V_ROWB + (16 * ((lane >> 4) & 1) + 4 * (lane & 3)) * 2;
    float m = -1e30f, l = 0.f;
    const float thr = 8.f / sl2;
    u32x4 kreg[NKC], vreg[2];
    const int ntiles = nct + nlt;
#define ATT_LOAD(T) do { const int _ko = (T) < nct ? (T) * 64 : lat_off + ((T) - nct) * 64; \
        _Pragma("unroll") for (int i = 0; i < NKC; ++i) { const int c = tid + 512 * i, key = c / CPR, part = c % CPR; kreg[i] = *(const u32x4*)(kbase + (size_t)(_ko + key) * kstride + part * 8); } \
        _Pragma("unroll") for (int i = 0; i < 2; ++i) { const int c = tid + 512 * i, key = c >> 4, part = c & 15; vreg[i] = *(const u32x4*)(vbase + (size_t)(_ko + key) * vstride + part * 8); } } while (0)
#define ATT_WRITE(B) do { LAS unsigned char* _kb = lds + (B) * KB_STRIDE; \
        _Pragma("unroll") for (int i = 0; i < NKC; ++i) { const int c = tid + 512 * i, key = c / CPR, part = c % CPR; *(LAS u32x4*)(_kb + (key * KS + part * 8) * 2) = kreg[i]; } \
        _Pragma("unroll") for (int i = 0; i < 2; ++i) { const int c = tid + 512 * i, key = c >> 4, part = c & 15; *(LAS u32x4*)(lds + VT_BASE + (B) * VT_STRIDE + key * V_ROWB + part * 16) = vreg[i]; } } while (0)
    ATT_LOAD(0);
    ATT_WRITE(0);
    if (ntiles > 1) ATT_LOAD(1);
    __syncthreads();
    for (int it = 0; it < ntiles; ++it) {
        const int koff = it < nct ? it * 64 : lat_off + (it - nct) * 64;
        const int buf = it & 1;
        if (it + 1 < ntiles) { ATT_WRITE(buf ^ 1); if (it + 2 < ntiles) ATT_LOAD(it + 2); }
        const LAS unsigned char* kbuf = lds + buf * KB_STRIDE; const LAS unsigned char* vbuf = lds + VT_BASE + buf * VT_STRIDE;
        bool skip = false, domask = false;
        int kj0 = 0;
        if (WINDOW && it >= nct) { kj0 = koff - 512; skip = (kj0 > q0 + 31 + 128) || (kj0 + 63 < q0 - 128); domask = !((kj0 >= q0 + 31 - 128) && (kj0 + 63 <= q0 + 128)); }
        if (!skip) {
            f32x16 s[2];
#pragma unroll
            for (int kb = 0; kb < 2; ++kb) {
#pragma unroll
                for (int i = 0; i < 16; ++i) s[kb][i] = 0.f;
#pragma unroll
                for (int ks = 0; ks < NKS; ++ks) { const bf16x8 ka = *(const LAS bf16x8*)(kbuf + ((kb * 32 + l32) * KS + ks * 16 + 8 * hi) * 2); s[kb] = MFMA32(ka, qf[ks], s[kb]); if (DK > 128 && (ks & 3) == 3) __builtin_amdgcn_sched_barrier(0); }
            }
            if (WINDOW) { if (domask) {
#pragma unroll
                for (int kb = 0; kb < 2; ++kb)
#pragma unroll
                    for (int i = 0; i < 16; ++i) { const int kj = kj0 + kb * 32 + crow(i, hi); const int d = (q0 + l32) - kj; if (d > 128 || d < -128) s[kb][i] = -1e30f; } } }
            float tmax = fmaxf(s[0][0], s[1][0]);
#pragma unroll
            for (int i = 1; i < 16; ++i) tmax = fmaxf(tmax, fmaxf(s[0][i], s[1][i]));
            tmax = fmaxf(tmax, __shfl_xor(tmax, 32));
            if (__any(tmax > m + thr)) {
                const float mnew = fmaxf(m, tmax); const float alpha = __builtin_amdgcn_exp2f((m - mnew) * sl2); m = mnew; l *= alpha;
#pragma unroll
                for (int db = 0; db < 4; ++db)
#pragma unroll
                    for (int i = 0; i < 16; ++i) o[db][i] *= alpha;
            }
            const float nmsc = -m * sl2;
            float psum = 0.f;
#pragma unroll
            for (int kb = 0; kb < 2; ++kb)
#pragma unroll
                for (int i = 0; i < 16; ++i) { const float p = __builtin_amdgcn_exp2f(fmaf(s[kb][i], sl2, nmsc)); s[kb][i] = p; psum += p; }
            l += psum;
            bf16x8 pf[2][2];
#pragma unroll
            for (int kb = 0; kb < 2; ++kb)
#pragma unroll
                for (int st = 0; st < 2; ++st) { u32x4 w; w.x = pk2(s[kb][8 * st], s[kb][8 * st + 1]); w.y = pk2(s[kb][8 * st + 2], s[kb][8 * st + 3]); w.z = pk2(s[kb][8 * st + 4], s[kb][8 * st + 5]); w.w = pk2(s[kb][8 * st + 6], s[kb][8 * st + 7]);
                    pf[kb][st] = __builtin_bit_cast(bf16x8, w); }
#pragma unroll
            for (int kb = 0; kb < 2; ++kb)
#pragma unroll
                for (int st = 0; st < 2; ++st)
#pragma unroll
                    for (int db = 0; db < 4; ++db) { const LAS unsigned char* vp = vbuf + vtr_off + (kb * 32 + 16 * st) * V_ROWB + db * 64;
                        const s16x4 v0 = vtr(vp), v1 = vtr(vp + 8 * V_ROWB);
                        const bf16x8 va = __builtin_shufflevector(v0, v1, 0, 1, 2, 3, 4, 5, 6, 7);
                        o[db] = MFMA32(va, pf[kb][st], o[db]); }
        }
        __syncthreads();
    }
#undef ATT_LOAD
#undef ATT_WRITE
    l += __shfl_xor(l, 32);
    if (has_sink) l += __builtin_amdgcn_exp2f(sinkl2 - m * sl2);
    const float inv = 1.f / l;
#pragma unroll
    for (int db = 0; db < 4; ++db)
#pragma unroll
        for (int i = 0; i < 16; ++i) o[db][i] *= inv;
}

constexpr int VT_OFF_SB = 32768;
template <int DK, bool WINDOW>
DI void attn_core_sb(f32x16 (&o)[4], const bf16* __restrict__ qp, const bf16* __restrict__ kbase, int kstride, const bf16* __restrict__ vbase, int vstride,
                  int nct, int lat_off, int nlt, float sl2, bool has_sink, float sinkl2, int q0, LAS unsigned char* lds, int tid) {
    constexpr int KS = DK + 8, NKS = DK / 16, NKC = DK / 64, CPR = DK / 8;
    const int lane = tid & 63, l32 = lane & 31, hi = lane >> 5;
    bf16x8 qf[NKS];
#pragma unroll
    for (int ks = 0; ks < NKS; ++ks) qf[ks] = *(const bf16x8*)(qp + ks * 16 + 8 * hi);
#pragma unroll
    for (int db = 0; db < 4; ++db)
#pragma unroll
        for (int i = 0; i < 16; ++i) o[db][i] = 0.f;
    const int vtr_off = (4 * hi + ((lane & 15) >> 2)) * V_ROWB + (16 * ((lane >> 4) & 1) + 4 * (lane & 3)) * 2;
    float m = -1e30f, l = 0.f;
    u32x4 kreg[NKC], vreg[2];
    const int ntiles = nct + nlt;
    {   const int koff = 0 < nct ? 0 : lat_off;
#pragma unroll
        for (int i = 0; i < NKC; ++i) { const int c = tid + 512 * i, key = c / CPR, part = c % CPR; kreg[i] = *(const u32x4*)(kbase + (size_t)(koff + key) * kstride + part * 8); }
#pragma unroll
        for (int i = 0; i < 2; ++i) { const int c = tid + 512 * i, key = c >> 4, part = c & 15; vreg[i] = *(const u32x4*)(vbase + (size_t)(koff + key) * vstride + part * 8); }
    }
    for (int it = 0; it < ntiles; ++it) {
        const int koff = it < nct ? it * 64 : lat_off + (it - nct) * 64;
        __syncthreads();
#pragma unroll
        for (int i = 0; i < NKC; ++i) { const int c = tid + 512 * i, key = c / CPR, part = c % CPR; *(LAS u32x4*)(lds + (key * KS + part * 8) * 2) = kreg[i]; }
#pragma unroll
        for (int i = 0; i < 2; ++i) { const int c = tid + 512 * i, key = c >> 4, part = c & 15; *(LAS u32x4*)(lds + VT_OFF_SB + key * V_ROWB + part * 16) = vreg[i]; }
        __syncthreads();
        if (it + 1 < ntiles) { const int kn = (it + 1) < nct ? (it + 1) * 64 : lat_off + (it + 1 - nct) * 64;
#pragma unroll
            for (int i = 0; i < NKC; ++i) { const int c = tid + 512 * i, key = c / CPR, part = c % CPR; kreg[i] = *(const u32x4*)(kbase + (size_t)(kn + key) * kstride + part * 8); }
#pragma unroll
            for (int i = 0; i < 2; ++i) { const int c = tid + 512 * i, key = c >> 4, part = c & 15; vreg[i] = *(const u32x4*)(vbase + (size_t)(kn + key) * vstride + part * 8); }
        }
        bool skip = false, domask = false;
        int kj0 = 0;
        if (WINDOW && it >= nct) { kj0 = koff - 512; skip = (kj0 > q0 + 31 + 128) || (kj0 + 63 < q0 - 128); domask = !((kj0 >= q0 + 31 - 128) && (kj0 + 63 <= q0 + 128)); }
        if (!skip) {
            f32x16 s[2];
#pragma unroll
            for (int kb = 0; kb < 2; ++kb) {
#pragma unroll
                for (int i = 0; i < 16; ++i) s[kb][i] = 0.f;
#pragma unroll
                for (int ks = 0; ks < NKS; ++ks) { const bf16x8 ka = *(const LAS bf16x8*)(lds + ((kb * 32 + l32) * KS + ks * 16 + 8 * hi) * 2); s[kb] = MFMA32(ka, qf[ks], s[kb]); }
            }
            float tmax = -1e30f;
#pragma unroll
            for (int kb = 0; kb < 2; ++kb)
#pragma unroll
                for (int i = 0; i < 16; ++i) { float x = s[kb][i] * sl2;
                    if (WINDOW) { if (domask) { const int kj = kj0 + kb * 32 + crow(i, hi); const int d = (q0 + l32) - kj; if (d > 128 || d < -128) x = -1e30f; } }
                    s[kb][i] = x; tmax = fmaxf(tmax, x); }
            tmax = fmaxf(tmax, __shfl_xor(tmax, 32));
            const float mnew = fmaxf(m, tmax); const float alpha = __builtin_amdgcn_exp2f(m - mnew); m = mnew;
            float psum = 0.f;
#pragma unroll
            for (int kb = 0; kb < 2; ++kb)
#pragma unroll
                for (int i = 0; i < 16; ++i) { const float p = __builtin_amdgcn_exp2f(s[kb][i] - m); s[kb][i] = p; psum += p; }
            l = l * alpha + psum;
#pragma unroll
            for (int db = 0; db < 4; ++db)
#pragma unroll
                for (int i = 0; i < 16; ++i) o[db][i] *= alpha;
            bf16x8 pf[2][2];
#pragma unroll
            for (int kb = 0; kb < 2; ++kb)
#pragma unroll
                for (int st = 0; st < 2; ++st) { u32x4 w; w.x = pk2(s[kb][8 * st], s[kb][8 * st + 1]); w.y = pk2(s[kb][8 * st + 2], s[kb][8 * st + 3]); w.z = pk2(s[kb][8 * st + 4], s[kb][8 * st + 5]); w.w = pk2(s[kb][8 * st + 6], s[kb][8 * st + 7]);
                    pf[kb][st] = __builtin_bit_cast(bf16x8, w); }
#pragma unroll
            for (int db = 0; db < 4; ++db)
#pragma unroll
                for (int kb = 0; kb < 2; ++kb)
#pragma unroll
                    for (int st = 0; st < 2; ++st) { const LAS unsigned char* vp = lds + VT_OFF_SB + vtr_off + (kb * 32 + 16 * st) * V_ROWB + db * 64;
                        const s16x4 v0 = vtr(vp), v1 = vtr(vp + 8 * V_ROWB);
                        const bf16x8 va = __builtin_shufflevector(v0, v1, 0, 1, 2, 3, 4, 5, 6, 7);
                        o[db] = MFMA32(va, pf[kb][st], o[db]); }
        }
    }
    l += __shfl_xor(l, 32);
    if (has_sink) l += __builtin_amdgcn_exp2f(sinkl2 - m);
    const float inv = 1.f / l;
#pragma unroll
    for (int db = 0; db < 4; ++db)
#pragma unroll
        for (int i = 0; i < 16; ++i) o[db][i] *= inv;
}

DI void attn_store(const f32x16 (&o)[4], bf16* orow  , int hi) {
#pragma unroll
    for (int db = 0; db < 4; ++db)
#pragma unroll
        for (int g = 0; g < 4; ++g) { u32x2 w; w.x = pk2(o[db][4 * g], o[db][4 * g + 1]); w.y = pk2(o[db][4 * g + 2], o[db][4 * g + 3]);
            *(u32x2*)(orow + db * 32 + 8 * g + 4 * hi) = w; }
}

DI void attn0_unit(int u, int& b, int& h, int& r0, int& kv0, int& nct) {
    if (u < 128) { const int bh = (u & 7) + 8 * (u >> 5), qb = (u >> 3) & 3; b = bh >> 3; h = bh & 7;
        r0 = NPT + b * 1024 + qb * 256; kv0 = NPT + b * 1536; nct = 24; }
    else { const int v = u - 128; b = v >> 3; h = v & 7; r0 = b * 256; kv0 = b * 256; nct = 4; }
}
DI void attn0_da_phase(const Args& a, LAS unsigned char* lds, int tid, int G) {
    unsigned char* ws = a.ws;
    const bf16 *QDA = (const bf16*)(ws + WS_QDA), *KDA = (const bf16*)(ws + WS_KDA), *VDA = (const bf16*)(ws + WS_VDA);
    bf16* O = (bf16*)(ws + WS_H);
    const float lam = ((const float*)(ws + WS_TAB))[TB_LAM];
    const int lane = tid & 63, wave = tid >> 6, l32 = lane & 31, hi = lane >> 5;
    const bool deal = (G == 256); const int c0 = (int)blockIdx.x;
    const int ufirst = !deal ? c0 : (c0 < 128 ? c0 : 128 + 2 * (c0 - 128)), ucount = !deal ? 384 : (c0 < 128 ? 1 : 2), ustep = deal ? 1 : G;
    for (int ui = 0, u = ufirst; (deal ? ui < ucount : u < 384); ++ui, u += ustep) {
        int b, h, r0, kv0, nct; attn0_unit(u, b, h, r0, kv0, nct);
        const int qrow = r0 + 32 * wave + l32;
        f32x16 o[4];
        f32x4* stash = (f32x4*)((float*)(ws + WS_XA) + ((size_t)blockIdx.x * NTHR + tid) * 64);
        attn_core<64, false>(o, QDA + (size_t)qrow * 1024 + h * 128, KDA + (size_t)kv0 * 1024 + h * 128, 1024, VDA + (size_t)kv0 * 1024 + h * 128, 1024,
                             nct, 0, 0, 0.125f * LOG2E, false, 0.f, 0, lds, tid);
#pragma unroll
        for (int db = 0; db < 4; ++db)
#pragma unroll
            for (int i = 0; i < 4; ++i) stash[db * 4 + i] = (f32x4){o[db][4 * i], o[db][4 * i + 1], o[db][4 * i + 2], o[db][4 * i + 3]};
        attn_core<64, false>(o, QDA + (size_t)qrow * 1024 + h * 128 + 64, KDA + (size_t)kv0 * 1024 + h * 128 + 64, 1024, VDA + (size_t)kv0 * 1024 + h * 128, 1024,
                             nct, 0, 0, 0.125f * LOG2E, false, 0.f, 0, lds, tid);
        float ss = 0.f;
#pragma unroll
        for (int db = 0; db < 4; ++db)
#pragma unroll
            for (int i = 0; i < 4; ++i) { const f32x4 sv = stash[db * 4 + i];
#pragma unroll
                for (int e = 0; e < 4; ++e) { const float c = sv[e] - lam * o[db][4 * i + e]; o[db][4 * i + e] = c; ss += c * c; } }
        ss += __shfl_xor(ss, 32);
        const float rs = rsqrtf(ss * (1.f / 128.f) + EPSF) * 0.8f;
#pragma unroll
        for (int db = 0; db < 4; ++db)
#pragma unroll
            for (int i = 0; i < 16; ++i) o[db][i] = o[db][i] * rs * a.in[24][db * 32 + crow(i, hi)];
        attn_store(o, O + (size_t)qrow * 2048 + h * 128, hi);
    }
}
DI void attn0_mla_phase(const Args& a, LAS unsigned char* lds, int tid, int G) {
    unsigned char* ws = a.ws;
    const bf16 *QM = (const bf16*)(ws + WS_QMLA), *KM = (const bf16*)(ws + WS_KMLA), *VM = (const bf16*)(ws + WS_VMLA);
    bf16* O = (bf16*)(ws + WS_H);
    const int lane = tid & 63, wave = tid >> 6, l32 = lane & 31, hi = lane >> 5;
    for (int u = G - 1 - (int)blockIdx.x; u < 384; u += G) {
        int b, h, r0, kv0, nct; attn0_unit(u, b, h, r0, kv0, nct);
        const int qrow = r0 + 32 * wave + l32;
        f32x16 o[4];
        attn_core_sb<192, false>(o, QM + (size_t)qrow * 1536 + h * 192, KM + (size_t)kv0 * 1536 + h * 192, 1536, VM + (size_t)kv0 * 1024 + h * 128, 1024,
                              nct, 0, 0, 0.07216878364870322f * LOG2E, false, 0.f, 0, lds, tid);
        attn_store(o, O + (size_t)qrow * 2048 + 1024 + h * 128, hi);
    }
}

DI void attn1_phase(const Args& a, LAS unsigned char* lds, int tid, int G) {
    unsigned char* ws = a.ws;
    const bf16 *QC = (const bf16*)(ws + WS_QC), *KC = (const bf16*)(ws + WS_KC), *VC = (const bf16*)(ws + WS_VC);
    bf16* O = (bf16*)(ws + WS_H);
    const int lane = tid & 63, wave = tid >> 6, l32 = lane & 31, hi = lane >> 5;
    const float sl2 = 0.08838834764831845f * LOG2E;
    for (int u = blockIdx.x; u < 256; u += G) {
        f32x16 o[4];
        const int xw = (u >> 3) & 15, gk = (u & 7) + 8 * (u >> 7);
        const int b = gk >> 2, h = 4 * (gk & 3) + (xw >> 2), qb = xw & 3; const int r0 = NPT + b * 1024 + qb * 256, kv0 = NPT + b * 1536;
        const int lo = (256 * qb - 128) < 0 ? 0 : (256 * qb - 128), hi_k = (256 * qb + 384) > 1024 ? 1024 : (256 * qb + 384);
        const int qrow = r0 + 32 * wave + l32; const int kvh = h >> 2;
        attn_core<128, true>(o, QC + (size_t)qrow * 2048 + h * 128, KC + (size_t)kv0 * 512 + kvh * 128, 512, VC + (size_t)kv0 * 512 + kvh * 128, 512,
                             8, 512 + lo, (hi_k - lo) >> 6, sl2, true, a.in[35][h] * LOG2E, 256 * qb + 32 * wave, lds, tid);
        attn_store(o, O + (size_t)qrow * 2048 + h * 128, hi);
    }
    for (int v = blockIdx.x; v < 512; v += G) {
        f32x16 o[4];
        const int cc = v & 255, grp = (cc & 7) + 8 * (cc >> 5) + 64 * (v >> 8);
        const int b = grp >> 2, h = 4 * (grp & 3) + ((cc >> 3) & 3); const int r0 = b * 256, kv0 = b * 256;
        const int qrow = r0 + 32 * wave + l32; const int kvh = h >> 2;
        attn_core<128, false>(o, QC + (size_t)qrow * 2048 + h * 128, KC + (size_t)kv0 * 512 + kvh * 128, 512, VC + (size_t)kv0 * 512 + kvh * 128, 512,
                              4, 0, 0, sl2, true, a.in[35][h] * LOG2E, 0, lds, tid);
        attn_store(o, O + (size_t)qrow * 2048 + h * 128, hi);
    }
}
#define XB_TMO      128
#define XB_XCNT(j)  (256  + 64 * (j))
#define XB_XSUB(j)  (1280 + 64 * (j))
#define XB_XGEN(j)  (2304 + 64 * (j))
#define XB_TOP      3328
#define XB_TOPGEN   3392
#define XCD_BAR_WORDS 3456
#define XB_SPIN_CAP (1u << 18)

__device__ __forceinline__ unsigned xb_ld(unsigned* p)              { return __hip_atomic_load(p, __ATOMIC_RELAXED, __HIP_MEMORY_SCOPE_AGENT); }
__device__ __forceinline__ unsigned xb_add(unsigned* p, unsigned v) { return __hip_atomic_fetch_add(p, v, __ATOMIC_RELAXED, __HIP_MEMORY_SCOPE_AGENT); }
__device__ __forceinline__ unsigned xb_xcc_id() { return (unsigned)__builtin_amdgcn_s_getreg((3 << 11) | 20) & 0xFu; }
#define XB_SPIN(cond, bar) do { unsigned _sp = 0; while (cond) { __builtin_amdgcn_s_sleep(1); \
    if ((++_sp & 255u) == 0u) { if (xb_ld(&(bar)[XB_TMO])) break; if (_sp > XB_SPIN_CAP) { atomicAdd(&(bar)[XB_TMO], 1u); break; } } } } while (0)

struct XcdBarrier {
    unsigned* bar; unsigned x;
    volatile LAS unsigned* st;
};

__device__ __forceinline__ XcdBarrier xcd_barrier_post(unsigned* bar, volatile LAS unsigned* st) {
    XcdBarrier b; b.bar = bar; b.x = xb_xcc_id(); b.st = st;
    if (threadIdx.x == 0) (void)xb_add(&bar[XB_XCNT(b.x)], 1u);
    return b;
}
__device__ __forceinline__ void xcd_barrier_complete(unsigned* bar, unsigned x, unsigned& nloc, unsigned& nx) {
    const unsigned G = gridDim.x * gridDim.y * gridDim.z;
    unsigned sum, cnt, mine, sp = 0u;
    for (;;) {
        sum = 0u; cnt = 0u; mine = 0u;
#pragma unroll
        for (unsigned j = 0; j < 16; ++j) { const unsigned c = xb_ld(&bar[XB_XCNT(j)]); sum += c; cnt += (c > 0u) ? 1u : 0u; mine = (j == x) ? c : mine; }
        if (sum == G) break;
        __builtin_amdgcn_s_sleep(1);
        if ((++sp & 255u) == 0u) { if (xb_ld(&bar[XB_TMO])) break; if (sp > XB_SPIN_CAP) { atomicAdd(&bar[XB_TMO], 1u); break; } }
    }
    nloc = mine > 0u ? mine : 1u; nx = cnt > 0u ? cnt : 1u;
}

__device__ __forceinline__ void xcd_barrier(const XcdBarrier& b) {
    asm volatile("s_waitcnt vmcnt(0)" ::: "memory");
    __syncthreads();
    if (threadIdx.x == 0) {
        unsigned* bar = b.bar;
        __builtin_amdgcn_s_waitcnt(0);
        unsigned nloc = b.st[0], nx = b.st[1];
        if (nloc == 0u) { xcd_barrier_complete(bar, b.x, nloc, nx); b.st[0] = nloc; b.st[1] = nx; }
        const unsigned old = xb_add(&bar[XB_XSUB(b.x)], 1u);
        const unsigned gen = old / nloc;
        if (old + 1u == (gen + 1u) * nloc) {
            __builtin_amdgcn_fence(__ATOMIC_RELEASE, "agent");
            asm volatile("s_waitcnt vmcnt(0)" ::: "memory");
            const unsigned og = xb_add(&bar[XB_TOP], 1u);
            const unsigned tg = og / nx;
            if (og + 1u == (tg + 1u) * nx) xb_add(&bar[XB_TOPGEN], 1u);
            else XB_SPIN(xb_ld(&bar[XB_TOPGEN]) == tg, bar);
            __builtin_amdgcn_fence(__ATOMIC_ACQUIRE, "agent");
            xb_add(&bar[XB_XGEN(b.x)], 1u);
            asm volatile("s_waitcnt vmcnt(0)" ::: "memory");
        } else {
            XB_SPIN(xb_ld(&bar[XB_XGEN(b.x)]) == gen, bar);
            __builtin_amdgcn_fence(__ATOMIC_ACQUIRE, "agent");
            asm volatile("s_waitcnt vmcnt(0)" ::: "memory");
        }
    }
    __syncthreads();
}

#ifndef DUP_DA
#define DUP_DA 1
#endif
#ifndef DUP_MLA
#define DUP_MLA 1
#endif
#ifndef MK_COOP
#define MK_COOP 1
#endif
constexpr int NPH = 20;
__global__ void __launch_bounds__(NTHR, 2) mega_fwd(Args a) {
    extern __shared__ __attribute__((aligned(16))) unsigned char lds_raw[];
    LAS unsigned char* lds = (LAS unsigned char*)lds_raw;
    const int tid = threadIdx.x, G = gridDim.x;
    const int lo = a.ph_lo, hi = a.ph_hi;
    volatile LAS unsigned* st = (volatile LAS unsigned*)(lds + LDS_BYTES - 16);
    if (tid < 4) st[tid] = 0u;
    __syncthreads();
    XcdBarrier bar; bar.bar = nullptr; bar.x = 0; bar.st = st;
#ifndef PHMASK
#define PHMASK 0xFFFFF
#endif
#ifndef DUPMASK
#define DUPMASK 0
#endif
#define REPS(k) (1 + ((DUPMASK >> (k)) & 1))
#define IN(k) (((PHMASK >> (k)) & 1) && lo <= (k) && (k) < hi)
#define SYNC(k) do { if (lo <= (k) && (k) + 1 < hi && a.coop) { if ((k) == 0) { cg::this_grid().sync(); bar = xcd_barrier_post(WSP(unsigned, WS_BAR), st); } else xcd_barrier(bar); } } while (0)
#define WSP(T, off) ((T*)(a.ws + (off)))
#define MODP ((const float*)(a.ws + WS_MOD))
#define XS_OFF (a.in[1] - (size_t)NPT * DM)
#define GEMM_BF16M(ACT, MODE, Aptr, Bptr, M_, N_, K_, Optr, cid, V2_, F2_) do { pg8::Gemm g{Aptr, Bptr, M_, N_, K_}; pg8::StaticOrder S; S.init(M_, N_, K_, G, cid); pg8::EpiBf16<ACT, MODE> E{Optr, N_, V2_, F2_}; \
        pg8::gemm_phase<pg8::EpiBf16<ACT, MODE>, pg8::StaticOrder, true, true>(lds, g, S, E); } while (0)
#define GEMM_BF16(ACT, Aptr, Bptr, M_, N_, K_, Optr, cid) GEMM_BF16M(ACT, 0, Aptr, Bptr, M_, N_, K_, Optr, cid, nullptr, nullptr)
#define GEMM_RES(Aptr, Bptr, K_, xp_, xs_, out_, gate_, fl_) do { pg8::Gemm g{Aptr, Bptr, NTOK, 2048, K_}; pg8::HalfShareOrder S; S.init(NTOK, 2048, K_, G, (int)blockIdx.x, (fl_) >= 0); pg8::EpiResid E{xp_, xs_, out_, gate_, WSP(f32x4, WS_PART), WSP(unsigned, WS_FLAGS) + 128 * ((fl_) < 0 ? 0 : (fl_))}; \
        pg8::gemm_phase<pg8::EpiResid, pg8::HalfShareOrder, true, true>(lds, g, S, E); } while (0)
    if (IN(0)) for (int rep = 0; rep < REPS(0); ++rep) phase0(a, lds, tid, G);
    SYNC(0);
    if (IN(1)) for (int rep = 0; rep < REPS(1); ++rep) norm_phase(a.in[0], XS_OFF, a.in[10], MODP, 0, 2048, WSP(bf16, WS_H), tid, G);
    SYNC(1);
    if (IN(2)) for (int rep = 0; rep < REPS(2); ++rep) { GEMM_BF16M(0, 2, WSP(const bf16, WS_H), WSP(const bf16, WS_WIN0), NTOK, ABP, 2048, WSP(bf16, WS_RAW), (int)blockIdx.x, WSP(bf16, WS_VDA), a.out + OUT_DAV); bg_convert(a, lds, tid, G, (NTOK / 256) * (ABP / 256), CI_A, CI_B); }
    SYNC(2);
    if (IN(3)) for (int rep = 0; rep < REPS(3); ++rep) postA_phase(a, tid, G);
    SYNC(3);
    if (IN(4)) for (int rep = 0; rep < REPS(4); ++rep) GEMM_BF16(0, WSP(const bf16, WS_MQN), WSP(const bf16, WS_WQUP), NTOK, 1536, 512, WSP(bf16, WS_RAW2), (int)blockIdx.x);
    if (IN(5)) for (int rep = 0; rep < REPS(5); ++rep) GEMM_BF16M(0, 1, WSP(const bf16, WS_CKV), WSP(const bf16, WS_WKVUP), NKV, 2048, 512, WSP(bf16, WS_RAW3), G - 1 - (int)blockIdx.x, WSP(bf16, WS_VMLA), nullptr);
    SYNC(5);
    if (IN(6)) for (int rep = 0; rep < REPS(6); ++rep) postB_phase(a, tid, G);
    SYNC(6);
    if (IN(7)) for (int rep = 0; rep < REPS(7); ++rep) {
#ifndef NO_DA
        _Pragma("unroll 1") for (int r2 = 0; r2 < (DUP_DA == 2 ? 1 + a.coop : 1); ++r2) attn0_da_phase(a, lds, tid, G);
#endif
#ifndef NO_MLA
        _Pragma("unroll 1") for (int r2 = 0; r2 < (DUP_MLA == 2 ? 1 + a.coop : 1); ++r2) attn0_mla_phase(a, lds, tid, G);
#endif
    }
    SYNC(7);
    if (IN(8)) for (int rep = 0; rep < REPS(8); ++rep) { GEMM_RES(WSP(const bf16, WS_H), WSP(const bf16, WS_WOUT0), 2048, a.in[0], XS_OFF, WSP(float, WS_XA), MODP + 2 * 2048, -1); bg_convert(a, lds, tid, G, (NTOK / 256) * 8, CI_B, CI_C); }
    SYNC(8);
    if (IN(9)) for (int rep = 0; rep < REPS(9); ++rep) norm_phase(WSP(const float, WS_XA), WSP(const float, WS_XA), a.in[11], MODP, 3 * 2048, 4 * 2048, WSP(bf16, WS_H), tid, G);
    SYNC(9);
    if (IN(10)) for (int rep = 0; rep < REPS(10); ++rep) GEMM_BF16(1, WSP(const bf16, WS_H), WSP(const bf16, WS_WFF1), NTOK, FFD, 2048, WSP(bf16, WS_FFH), (int)blockIdx.x);
    SYNC(10);
    if (IN(11)) for (int rep = 0; rep < REPS(11); ++rep) { GEMM_RES(WSP(const bf16, WS_FFH), WSP(const bf16, WS_WFF2), FFD, WSP(const float, WS_XA), WSP(const float, WS_XA), WSP(float, WS_XB), MODP + 5 * 2048, 1); }
    SYNC(11);
    if (IN(12)) for (int rep = 0; rep < REPS(12); ++rep) norm_phase(WSP(const float, WS_XB), WSP(const float, WS_XB), a.in[10] + 2048, MODP + 5 * 12288, 0, 2048, WSP(bf16, WS_H), tid, G);
    SYNC(12);
    if (IN(13)) for (int rep = 0; rep < REPS(13); ++rep) { GEMM_BF16M(0, 3, WSP(const bf16, WS_H), WSP(const bf16, WS_WCIN), NTOK, 3072, 2048, WSP(bf16, WS_RAWC), (int)blockIdx.x, WSP(bf16, WS_VC), a.out + OUT_GQV); bg_convert(a, lds, tid, G, (NTOK / 256) * 12, CI_C, CI_END); }
    SYNC(13);
    if (IN(14)) for (int rep = 0; rep < REPS(14); ++rep) postC_phase(a, tid, G);
    SYNC(14);
    if (IN(15)) for (int rep = 0; rep < REPS(15); ++rep) attn1_phase(a, lds, tid, G);
    SYNC(15);
    if (IN(16)) for (int rep = 0; rep < REPS(16); ++rep) GEMM_RES(WSP(const bf16, WS_H), WSP(const bf16, WS_WCOUT), 2048, WSP(const float, WS_XB), WSP(const float, WS_XB), WSP(float, WS_XA), MODP + 5 * 12288 + 2 * 2048, 2);
    SYNC(16);
    if (IN(17)) for (int rep = 0; rep < REPS(17); ++rep) norm_phase(WSP(const float, WS_XA), WSP(const float, WS_XA), a.in[11] + 2048, MODP + 5 * 12288, 3 * 2048, 4 * 2048, WSP(bf16, WS_H), tid, G);
    SYNC(17);
    if (IN(18)) for (int rep = 0; rep < REPS(18); ++rep) GEMM_BF16(1, WSP(const bf16, WS_H), WSP(const bf16, WS_WFF1) + (size_t)FFD * 2048, NTOK, FFD, 2048, WSP(bf16, WS_FFH), (int)blockIdx.x);
    SYNC(18);
    if (IN(19)) for (int rep = 0; rep < REPS(19); ++rep) GEMM_RES(WSP(const bf16, WS_FFH), WSP(const bf16, WS_WFF2) + (size_t)FFD * 2048, FFD, WSP(const float, WS_XA), WSP(const float, WS_XA), a.out + OUT_Y, MODP + 5 * 12288 + 5 * 2048, 3);
}

extern "C" void kernel_launch(void* const* d_in, const int* in_sizes, int n_in, void* d_out, int out_size, void* d_ws, size_t ws_size, hipStream_t stream) {
    static int grid = 0;
    if (grid == 0) {
        if (n_in != 36 || ws_size < WS_END) { fprintf(stderr, "kernel_launch: unexpected n_in %d / ws %zu (need %zu)\n", n_in, ws_size, (size_t)WS_END); grid = -1; return; }
        int dev = 0, cus = 0, per_cu = 0;
        hipGetDevice(&dev); hipDeviceGetAttribute(&cus, hipDeviceAttributeMultiprocessorCount, dev);
        if (hipFuncSetAttribute((const void*)mega_fwd, hipFuncAttributeMaxDynamicSharedMemorySize, LDS_BYTES) != hipSuccess) { fprintf(stderr, "kernel_launch: hipFuncSetAttribute failed\n"); grid = -1; return; }
        if (hipOccupancyMaxActiveBlocksPerMultiprocessor(&per_cu, (const void*)mega_fwd, NTHR, LDS_BYTES) != hipSuccess || per_cu < 1) { fprintf(stderr, "kernel_launch: occupancy query says %d\n", per_cu); per_cu = 1; }
        (void)hipGetLastError();
        grid = cus * per_cu;
        fprintf(stderr, "kernel_launch: grid %d (cus %d x %d)\n", grid, cus, per_cu);
    }
    if (grid < 0) return;
    Args a{};
    for (int i = 0; i < 36; ++i) a.in[i] = (const float*)d_in[i];
    a.out = (float*)d_out; a.ws = (unsigned char*)d_ws;
#if MK_COOP
    a.ph_lo = 0; a.ph_hi = NPH; a.coop = 1;
    void* args[] = {&a};
    hipError_t e = hipLaunchCooperativeKernel((const void*)mega_fwd, dim3(grid), dim3(NTHR), args, LDS_BYTES, stream);
    if (e != hipSuccess) fprintf(stderr, "cooperative launch failed: %s (grid %d)\n", hipGetErrorString(e), grid);
#else
#ifndef HOSTDUP
#define HOSTDUP 0
#endif
    for (int ph = 0; ph < NPH; ++ph) { a.ph_lo = ph; a.ph_hi = ph + 1; a.coop = 0;
        for (int rep = 0; rep < 1 + ((HOSTDUP >> ph) & 1); ++rep) hipLaunchKernelGGL(mega_fwd, dim3(grid), dim3(NTHR), LDS_BYTES, stream, a); }
#endif
}
```
